# Optimizing an MI355X kernel written in HIP

```python
import math
import jax, jax.numpy as jnp
from jax import lax
import numpy as np

D_MODEL = 1024
BATCH = 8
SEQ = 2048
DEPTH = 2

HEAD_DIM = 64
SB_HEADS = 8
SWA_Q_HEADS = 8
SWA_KV_HEADS = 2
SWA_GROUP = SWA_Q_HEADS // SWA_KV_HEADS
WINDOW = 128
BLOCK = 128
N_BUCKETS = 32
MAX_DISTANCE = 128
D_FF = 2816
EPS = 1e-6
NEG_INF = -1e30

SB_WIDTH = SB_HEADS * HEAD_DIM
SWA_WIDTH = SWA_Q_HEADS * HEAD_DIM
KV_WIDTH = SWA_KV_HEADS * HEAD_DIM
MIX_WIDTH = SB_WIDTH + SWA_WIDTH
IN_WIDTH = 3 * SB_WIDTH + SWA_WIDTH + 2 * KV_WIDTH
SPLITS = (SB_WIDTH, 2 * SB_WIDTH, 3 * SB_WIDTH,
          3 * SB_WIDTH + SWA_WIDTH, 3 * SB_WIDTH + SWA_WIDTH + KV_WIDTH)

kernel_name = "hymba_stickbreak_swa_sink_macaron"


def rms_norm(x, g):
    xf = x.astype(jnp.float32)
    y = xf * lax.rsqrt(jnp.mean(xf * xf, axis=-1, keepdims=True) + EPS)
    return (y * g.astype(jnp.float32)).astype(x.dtype)


def swiglu(x, w_gu, w_down):
    gate, up = jnp.split(x @ w_gu, 2, axis=-1)
    return (jax.nn.silu(gate) * up) @ w_down


def t5_causal_bucket(dist):
    max_exact = N_BUCKETS // 2
    d = jnp.maximum(dist, 1).astype(jnp.float32)
    large = max_exact + (jnp.log(d / max_exact) / math.log(MAX_DISTANCE / max_exact)
                         * (N_BUCKETS - max_exact)).astype(jnp.int32)
    large = jnp.minimum(large, N_BUCKETS - 1)
    return jnp.where(dist < max_exact, dist, large)


def stick_breaking_attention(q, k, v):
    B, S = q.shape[:2]
    nblk = S // BLOCK
    outs = []
    for i in range(nblk):
        L = (i + 1) * BLOCK
        qi = q[:, i * BLOCK:L]
        z = jnp.einsum('bqhd,bkhd->bhqk', qi, k[:, :L],
                       preferred_element_type=jnp.float32) * (HEAD_DIM ** -0.5)
        t_pos = i * BLOCK + jnp.arange(BLOCK)[:, None]
        s_pos = jnp.arange(L)[None, :]
        causal = s_pos < t_pos
        neg_log_keep = jnp.where(causal, jax.nn.softplus(z), 0.0)
        suffix = lax.cumsum(neg_log_keep, axis=3, reverse=True) - neg_log_keep
        log_w = jax.nn.log_sigmoid(z) - suffix
        w = jnp.where(causal, jnp.exp(log_w), 0.0).astype(v.dtype)
        outs.append(jnp.einsum('bhqk,bkhd->bqhd', w, v[:, :L]))
    return jnp.concatenate(outs, axis=1).reshape(B, S, SB_WIDTH)


def sliding_window_sink_attention(q, k, v, sinks, rel_bias):
    B, S = q.shape[:2]
    nblk = S // BLOCK
    qb = q.reshape(B, nblk, BLOCK, SWA_KV_HEADS, SWA_GROUP, HEAD_DIM)

    def band(t):
        tp = jnp.pad(t, ((0, 0), (BLOCK, 0), (0, 0), (0, 0)))
        prev = tp[:, :S].reshape(B, nblk, BLOCK, SWA_KV_HEADS, HEAD_DIM)
        cur = t.reshape(B, nblk, BLOCK, SWA_KV_HEADS, HEAD_DIM)
        return jnp.concatenate([prev, cur], axis=2)

    kb, vb = band(k), band(v)
    scores = jnp.einsum('bnqhgd,bnkhd->bnhgqk', qb, kb,
                        preferred_element_type=jnp.float32) * (HEAD_DIM ** -0.5)
    a = jnp.arange(BLOCK)[:, None]
    c = jnp.arange(2 * BLOCK)[None, :]
    dist = BLOCK + a - c
    bias = rel_bias.astype(jnp.float32)[t5_causal_bucket(jnp.maximum(dist, 0))]
    bias = bias.transpose(2, 0, 1).reshape(SWA_KV_HEADS, SWA_GROUP, BLOCK, 2 * BLOCK)
    in_band = (dist >= 0) & (dist < WINDOW)
    key_exists = (jnp.arange(nblk)[:, None] > 0) | (c >= BLOCK)
    mask = in_band[None] & key_exists[:, None, :]
    scores = jnp.where(mask[None, :, None, None], scores + bias, NEG_INF)
    sink = sinks.astype(jnp.float32).reshape(SWA_KV_HEADS, SWA_GROUP)[None, None, :, :, None, None]
    m = jnp.maximum(jnp.max(scores, axis=-1, keepdims=True), sink)
    p = jnp.exp(scores - m)
    p = (p / (jnp.sum(p, axis=-1, keepdims=True) + jnp.exp(sink - m))).astype(v.dtype)
    out = jnp.einsum('bnhgqk,bnkhd->bnqhgd', p, vb)
    return out.reshape(B, S, SWA_WIDTH)


def setup_inputs(seed: int = 0) -> dict:
    key = jax.random.key(seed)
    ks = jax.random.split(key, 16)
    f32 = jnp.float32

    def w(k, shape, fan_in):
        return jax.random.normal(k, shape, f32) * (fan_in ** -0.5)

    def gain(k, shape):
        return 1.0 + 0.02 * jax.random.normal(k, shape, f32)

    return {
        "x": jax.random.normal(ks[0], (BATCH, SEQ, D_MODEL), f32),
        "norm_ffn1": gain(ks[1], (DEPTH, D_MODEL)),
        "w_ffn1_gu": w(ks[2], (DEPTH, D_MODEL, 2 * D_FF), D_MODEL),
        "w_ffn1_down": w(ks[3], (DEPTH, D_FF, D_MODEL), D_FF),
        "norm_mix": gain(ks[4], (DEPTH, D_MODEL)),
        "w_in": w(ks[5], (DEPTH, D_MODEL, IN_WIDTH), D_MODEL),
        "sinks": 0.5 * jax.random.normal(ks[6], (DEPTH, SWA_Q_HEADS), f32),
        "norm_out_sb": gain(ks[7], (DEPTH, SB_WIDTH)),
        "norm_out_swa": gain(ks[8], (DEPTH, SWA_WIDTH)),
        "w_out": w(ks[9], (DEPTH, MIX_WIDTH, D_MODEL), MIX_WIDTH),
        "norm_ffn2": gain(ks[10], (DEPTH, D_MODEL)),
        "w_ffn2_gu": w(ks[11], (DEPTH, D_MODEL, 2 * D_FF), D_MODEL),
        "w_ffn2_down": w(ks[12], (DEPTH, D_FF, D_MODEL), D_FF),
        "rel_bias": 0.5 * jax.random.normal(ks[13], (N_BUCKETS, SWA_Q_HEADS), f32),
        "norm_final": gain(ks[14], (D_MODEL,)),
    }


def reference(x, norm_ffn1, w_ffn1_gu, w_ffn1_down, norm_mix, w_in, sinks,
              norm_out_sb, norm_out_swa, w_out, norm_ffn2, w_ffn2_gu, w_ffn2_down,
              rel_bias, norm_final):
    B, S, _ = x.shape
    h = x
    for l in range(DEPTH):
        h = h + 0.5 * swiglu(rms_norm(h, norm_ffn1[l]), w_ffn1_gu[l], w_ffn1_down[l])
        n = rms_norm(h, norm_mix[l])
        proj = n @ w_in[l]
        q_sb, k_sb, v_sb, q_sw, k_sw, v_sw = jnp.split(proj, SPLITS, axis=-1)
        o_sb = stick_breaking_attention(
            q_sb.reshape(B, S, SB_HEADS, HEAD_DIM),
            k_sb.reshape(B, S, SB_HEADS, HEAD_DIM),
            v_sb.reshape(B, S, SB_HEADS, HEAD_DIM))
        o_sw = sliding_window_sink_attention(
            q_sw.reshape(B, S, SWA_Q_HEADS, HEAD_DIM),
            k_sw.reshape(B, S, SWA_KV_HEADS, HEAD_DIM),
            v_sw.reshape(B, S, SWA_KV_HEADS, HEAD_DIM),
            sinks[l], rel_bias)
        mixed = jnp.concatenate([rms_norm(o_sb, norm_out_sb[l]),
                                 rms_norm(o_sw, norm_out_swa[l])], axis=-1)
        h = h + mixed @ w_out[l]
        h = h + 0.5 * swiglu(rms_norm(h, norm_ffn2[l]), w_ffn2_gu[l], w_ffn2_down[l])
    return rms_norm(h, norm_final)
```

```cpp
#include <hip/hip_runtime.h>
#include <cstdio>
#include <cstdint>

namespace pg8 {
#define PG8_LAS __attribute__((address_space(3)))
typedef unsigned short bf16_t;
typedef short bf16x8 __attribute__((ext_vector_type(8)));
typedef float f32x4 __attribute__((ext_vector_type(4)));
typedef unsigned u32x4 __attribute__((ext_vector_type(4)));
constexpr int BM = 256, BK = 64, HALF = 128, HTB = HALF * BK * 2  , STAGE_BYTES = 8 * HTB, NXCD = 8, WGM = 8;

__host__ __device__ __forceinline__ int lds_byte(int r, int c) { const int st = (r >> 4) * 2 + (c >> 5), rr = r & 15, cc = c & 31, ob = rr * 64 + cc * 2; return st * 1024 + (ob ^ (((ob >> 9) & 1) << 5)); }
__host__ __device__ __forceinline__ void stage_rc(int b, int& R, int& C) { const int st = b / 1024, sb = b % 1024, swz = sb ^ (((sb >> 9) & 1) << 5); R = (st >> 1) * 16 + swz / 64; C = (st & 1) * 32 + (swz % 64) / 2; }
__host__ __device__ __forceinline__ int perm32(int rho) { const int n = rho >> 4, i = rho & 15; return 8 * (i >> 2) + 4 * n + (i & 3); }

struct Unit { int pm, pn; };
struct Gemm { const bf16_t* A; const bf16_t* Bt; int M, N, K; };

struct StaticOrder {
    int nM, nN, nwg, G, c;
    __host__ __device__ void init(int M, int N, int G_, int c_) { nM = M / BM; nN = N / BM; nwg = nM * nN; G = G_; c = c_; }
    __host__ __device__ bool next(int i, Unit& u) const {
        const long L = (long)i * G + c; if (L >= nwg) return false;
        int wgid = (int)L; { const int q = nwg / NXCD, r = nwg % NXCD, xcd = wgid % NXCD, off = wgid / NXCD; wgid = (xcd < r ? xcd * (q + 1) : r * (q + 1) + (xcd - r) * q) + off; }
        const int nig = WGM * nN, gid = wgid / nig, fm = gid * WGM, gsz = (nM - fm) < WGM ? (nM - fm) : WGM;
        u.pm = fm + ((wgid % nig) % gsz); u.pn = (wgid % nig) / gsz; return true;
    }
    __device__ __forceinline__ void a_ready(const Unit&) const {}
    __device__ __forceinline__ void done(const Unit&) const {}
};

__device__ __forceinline__ unsigned cvt_pk_bf16(float lo, float hi) { unsigned r; asm volatile("v_cvt_pk_bf16_f32 %0, %1, %2" : "=v"(r) : "v"(lo), "v"(hi)); return r; }
constexpr float RMS_EPS = 1e-6f;
__device__ __forceinline__ float row_rstd(const float* ssp, int row, float inv_n) { const f32x4 p = *(const f32x4*)(ssp + 4 * (size_t)row); return __builtin_amdgcn_rsqf(((p[0] + p[1]) + (p[2] + p[3])) * inv_n + RMS_EPS); }
__device__ __forceinline__ float silu_mul(float g, float u) { const float e = __builtin_amdgcn_exp2f(g * -1.4426950408889634f); return g * __builtin_amdgcn_rcpf(1.0f + e) * u; }

struct EpiSwiGLU {
    static constexpr bool PERM = true, AFTER_DRAIN = false;
    bf16_t* O; int ldc; const float* ssp;
    __device__ __forceinline__ void operator()(const f32x4 (&acc)[2][2][4][2], const Unit& u, int wr, int wc, int fr, int fq) const {
        const int row0 = u.pm * BM + wr * 64 + fr, col0 = u.pn * HALF + wc * 32 + 8 * fq;
#pragma unroll
        for (int ai = 0; ai < 2; ++ai)
#pragma unroll
            for (int m = 0; m < 4; ++m) { const int row = row0 + ai * HALF + m * 16; const float rs = row_rstd(ssp, row, 1.0f / 1024.0f);
                const f32x4 g0 = acc[ai][0][m][0] * rs, g1 = acc[ai][0][m][1] * rs, u0 = acc[ai][1][m][0] * rs, u1 = acc[ai][1][m][1] * rs;
                u32x4 w; w.x = cvt_pk_bf16(silu_mul(g0[0], u0[0]), silu_mul(g0[1], u0[1])); w.y = cvt_pk_bf16(silu_mul(g0[2], u0[2]), silu_mul(g0[3], u0[3]));
                w.z = cvt_pk_bf16(silu_mul(g1[0], u1[0]), silu_mul(g1[1], u1[1])); w.w = cvt_pk_bf16(silu_mul(g1[2], u1[2]), silu_mul(g1[3], u1[3]));
                *(u32x4*)(O + (size_t)row * ldc + col0) = w; }
    }
};
struct EpiProj {
    static constexpr bool PERM = true, AFTER_DRAIN = false;
    bf16_t* O; int ldc; const float* ssp; unsigned qmask; float qscale;
    __device__ __forceinline__ void operator()(const f32x4 (&acc)[2][2][4][2], const Unit& u, int wr, int wc, int fr, int fq) const {
        const int row0 = u.pm * BM + wr * 64 + fr, col0 = u.pn * BM + wc * 32 + 8 * fq;
        const float sc = ((qmask >> u.pn) & 1u) ? qscale : 1.0f;
#pragma unroll
        for (int ai = 0; ai < 2; ++ai)
#pragma unroll
            for (int m = 0; m < 4; ++m) { const int row = row0 + ai * HALF + m * 16; const float rs = row_rstd(ssp, row, 1.0f / 1024.0f) * sc;
#pragma unroll
                for (int bj = 0; bj < 2; ++bj) { const f32x4 v0 = acc[ai][bj][m][0] * rs, v1 = acc[ai][bj][m][1] * rs;
                    u32x4 w; w.x = cvt_pk_bf16(v0[0], v0[1]); w.y = cvt_pk_bf16(v0[2], v0[3]); w.z = cvt_pk_bf16(v1[0], v1[1]); w.w = cvt_pk_bf16(v1[2], v1[3]);
                    *(u32x4*)(O + (size_t)row * ldc + col0 + bj * HALF) = w; } }
    }
};
struct EpiRes {
    static constexpr bool PERM = true, AFTER_DRAIN = true;
    const float* base; float* out; bf16_t* hb; float* ssp; float alpha;
    __device__ __forceinline__ void fused(f32x4 (&acc)[2][2][4][2], const Unit& u, int wr, int wc, int fr, int fq, PG8_LAS unsigned char* lds, int wid, int lane) const {
        PG8_LAS float* P = (PG8_LAS float*)lds;
        const int col0 = u.pn * BM + wc * 32 + 8 * fq;
#pragma unroll
        for (int ai = 0; ai < 2; ++ai)
#pragma unroll
            for (int m = 0; m < 4; ++m) { const int rl = ai * HALF + wr * 64 + m * 16 + fr; const size_t off = (size_t)(u.pm * BM + rl) * 1024 + col0; float s = 0.f;
#pragma unroll
                for (int bj = 0; bj < 2; ++bj) { const f32x4 b0 = *(const f32x4*)(base + off + bj * HALF), b1 = *(const f32x4*)(base + off + bj * HALF + 4);
                    const f32x4 v0 = b0 + acc[ai][bj][m][0] * alpha, v1 = b1 + acc[ai][bj][m][1] * alpha;
                    *(f32x4*)(out + off + bj * HALF) = v0; *(f32x4*)(out + off + bj * HALF + 4) = v1;
                    u32x4 w; w.x = cvt_pk_bf16(v0[0], v0[1]); w.y = cvt_pk_bf16(v0[2], v0[3]); w.z = cvt_pk_bf16(v1[0], v1[1]); w.w = cvt_pk_bf16(v1[2], v1[3]);
                    *(u32x4*)(hb + off + bj * HALF) = w;
                    s += (v0[0] * v0[0] + v0[1] * v0[1]) + (v0[2] * v0[2] + v0[3] * v0[3]) + (v1[0] * v1[0] + v1[1] * v1[1]) + (v1[2] * v1[2] + v1[3] * v1[3]); }
                s += __shfl_xor(s, 16); s += __shfl_xor(s, 32);
                if (fq == 0) P[rl * 4 + wc] = s; }
        asm volatile("s_waitcnt lgkmcnt(0)" ::: "memory"); __builtin_amdgcn_s_barrier(); asm volatile("" ::: "memory");
        const int t = wid * 64 + lane;
        if (t < 256) { const f32x4 p = *(const PG8_LAS f32x4*)(P + t * 4); ssp[(size_t)(u.pm * BM + t) * 4 + u.pn] = (p[0] + p[1]) + (p[2] + p[3]); }
        asm volatile("s_waitcnt lgkmcnt(0)" ::: "memory"); __builtin_amdgcn_s_barrier(); asm volatile("" ::: "memory");
    }
};


template <class Epi, class Sched, bool ALIGN_EPI = false, bool SP2 = false>
__device__ __forceinline__ void gemm_phase(PG8_LAS unsigned char* lds, const Gemm g, const Sched& S, const Epi& E) {
    int tid_ = threadIdx.x; asm volatile("" : "+v"(tid_));
    const int tid = tid_, wid = __builtin_amdgcn_readfirstlane(tid >> 6), lane = tid & 63, wr = wid >> 2, wc = wid & 3, fr = lane & 15, fq = lane >> 4;
    const int K = g.K, nt = K / BK;
    unsigned voffA[2], voffB[2];
#pragma unroll
    for (int i = 0; i < 2; ++i) { int R, C; stage_rc(tid * 16 + i * 8192, R, C); const int Rb = Epi::PERM ? ((R & ~31) + perm32(R & 31)) : R;
        voffA[i] = (unsigned)(R * K + C) * 2u; voffB[i] = (unsigned)(Rb * K + C) * 2u; }
    const size_t kstep = (size_t)(BK * 2);
    const size_t hstep = (size_t)HALF * K * 2;
    const size_t tstep = 2 * hstep;
    const unsigned ldsw = (unsigned)wid * 1024u;
    const int aoff = lds_byte(wr * 64 + fr, fq * 8), boff = lds_byte(wc * 32 + fr, fq * 8);
#define PG8_SA(b, h) (((b) * 2 + (h)) * HTB)
#define PG8_SB(b, h) ((4 + (b) * 2 + (h)) * HTB)
#define PG8_STAGE(bufoff, gbase, voff) do { _Pragma("unroll") for (int _i = 0; _i < 2; ++_i) \
        __builtin_amdgcn_global_load_lds((const unsigned*)((const char*)(gbase) + (voff)[_i]), (PG8_LAS unsigned*)(lds + (bufoff) + ldsw + _i * 8192), 16, 0, 0); } while (0)
#define PG8_LDA(dst, b, h) do { _Pragma("unroll") for (int m = 0; m < 4; ++m) _Pragma("unroll") for (int k = 0; k < 2; ++k) dst[m][k] = *(const PG8_LAS bf16x8*)(lds + PG8_SA(b, h) + aoff + m * 2048 + k * 1024); } while (0)
#define PG8_LDB(dst, b, h) do { _Pragma("unroll") for (int n = 0; n < 2; ++n) _Pragma("unroll") for (int k = 0; k < 2; ++k) dst[n][k] = *(const PG8_LAS bf16x8*)(lds + PG8_SB(b, h) + boff + n * 2048 + k * 1024); } while (0)
#define PG8_MMA(ai, bj, At, Bt) do { __builtin_amdgcn_s_setprio(1); _Pragma("unroll") for (int m = 0; m < 4; ++m) _Pragma("unroll") for (int n = 0; n < 2; ++n) _Pragma("unroll") for (int k = 0; k < 2; ++k) \
        acc[ai][bj][m][n] = __builtin_amdgcn_mfma_f32_16x16x32_bf16(Bt[n][k], At[m][k], acc[ai][bj][m][n], 0, 0, 0); __builtin_amdgcn_s_setprio(0); } while (0)
#define PG8_WAIT_V(n) asm volatile("s_waitcnt vmcnt(" #n ")" ::: "memory")
#define PG8_WAIT_L(n) asm volatile("s_waitcnt lgkmcnt(" #n ")" ::: "memory")
#define PG8_BAR __builtin_amdgcn_s_barrier()
#define PG8_SCHED __builtin_amdgcn_sched_barrier(0)
    Unit cur, nxt; int ui = 0;
    if (!S.next(0, cur)) return;
    f32x4 acc[2][2][4][2];
#pragma unroll
    for (int a = 0; a < 2; ++a)
#pragma unroll
        for (int b = 0; b < 2; ++b)
#pragma unroll
            for (int m = 0; m < 4; ++m)
#pragma unroll
                for (int n = 0; n < 2; ++n) acc[a][b][m][n] = (f32x4){0.f, 0.f, 0.f, 0.f};
    bf16x8 At[4][2], B0[2][2], B1[2][2];
    const char* cA = (const char*)g.A + (size_t)cur.pm * tstep; const char* cB = (const char*)g.Bt + (size_t)cur.pn * tstep;
    S.a_ready(cur);
    if constexpr (SP2) {
        PG8_STAGE(PG8_SB(0, 0), cB, voffB); PG8_STAGE(PG8_SB(0, 1), cB + hstep, voffB); PG8_STAGE(PG8_SA(0, 0), cA, voffA); PG8_STAGE(PG8_SA(0, 1), cA + hstep, voffA);
        if (wr == 1) PG8_BAR;
        PG8_WAIT_V(2); PG8_BAR;
        PG8_STAGE(PG8_SB(1, 0), cB + kstep, voffB); PG8_STAGE(PG8_SA(1, 0), cA + kstep, voffA); PG8_STAGE(PG8_SB(1, 1), cB + hstep + kstep, voffB);
        PG8_WAIT_V(6); PG8_BAR;
    } else {
        PG8_STAGE(PG8_SB(0, 0), cB, voffB); PG8_STAGE(PG8_SA(0, 0), cA, voffA); PG8_STAGE(PG8_SB(0, 1), cB + hstep, voffB); PG8_STAGE(PG8_SA(0, 1), cA + hstep, voffA);
        if (wr == 1) PG8_BAR;
        PG8_WAIT_V(4); PG8_BAR;
        PG8_STAGE(PG8_SB(1, 0), cB + kstep, voffB); PG8_STAGE(PG8_SA(1, 0), cA + kstep, voffA); PG8_STAGE(PG8_SB(1, 1), cB + hstep + kstep, voffB);
        PG8_WAIT_V(6); PG8_BAR;
    }
    for (;;) {
        const bool has_next = S.next(ui + 1, nxt);
        const char* nA = has_next ? (const char*)g.A + (size_t)nxt.pm * tstep : cA; const char* nB = has_next ? (const char*)g.Bt + (size_t)nxt.pn * tstep : cB;
        for (int t = 0; t < nt; t += 2) {
            const bool last = (t == nt - 2);
            const char* a1 = cA + (size_t)(t + 1) * kstep;
            const char* a2 = last ? nA : cA + (size_t)(t + 2) * kstep; const char* b2 = last ? nB : cB + (size_t)(t + 2) * kstep;
            const char* a3 = a2 + kstep; const char* b3 = b2 + kstep;
            if (last && has_next) S.a_ready(nxt);
            if constexpr (SP2) {
            PG8_LDB(B0, 0, 0); PG8_LDB(B1, 0, 1); PG8_SCHED; PG8_LDA(At, 0, 0); PG8_STAGE(PG8_SA(1, 1), a1 + hstep, voffA);
            PG8_WAIT_V(8); PG8_WAIT_L(0); PG8_BAR; PG8_MMA(0, 0, At, B0); PG8_MMA(0, 1, At, B1); PG8_BAR; PG8_SCHED;
            PG8_LDA(At, 0, 1); PG8_STAGE(PG8_SB(0, 0), b2, voffB); PG8_STAGE(PG8_SB(0, 1), b2 + hstep, voffB); PG8_STAGE(PG8_SA(0, 0), a2, voffA);
            PG8_WAIT_V(8); PG8_WAIT_L(0); PG8_BAR; PG8_MMA(1, 0, At, B0); PG8_MMA(1, 1, At, B1); PG8_BAR; PG8_SCHED;
            PG8_LDB(B0, 1, 0); PG8_LDB(B1, 1, 1); PG8_SCHED; PG8_LDA(At, 1, 0); PG8_STAGE(PG8_SA(0, 1), a2 + hstep, voffA);
            PG8_WAIT_V(8); PG8_WAIT_L(0); PG8_BAR; PG8_MMA(0, 0, At, B0); PG8_MMA(0, 1, At, B1); PG8_BAR; PG8_SCHED;
            PG8_LDA(At, 1, 1); PG8_STAGE(PG8_SB(1, 0), b3, voffB); PG8_STAGE(PG8_SB(1, 1), b3 + hstep, voffB); PG8_STAGE(PG8_SA(1, 0), a3, voffA);
            PG8_WAIT_V(8); PG8_WAIT_L(0); PG8_BAR; PG8_MMA(1, 0, At, B0); PG8_MMA(1, 1, At, B1); PG8_BAR; PG8_SCHED;
            } else {
            PG8_LDB(B0, 0, 0); PG8_SCHED; PG8_LDA(At, 0, 0); PG8_STAGE(PG8_SA(1, 1), a1 + hstep, voffA);
            PG8_WAIT_L(8); PG8_BAR; PG8_WAIT_L(0); PG8_MMA(0, 0, At, B0); PG8_BAR; PG8_SCHED;
            PG8_LDB(B1, 0, 1); PG8_STAGE(PG8_SB(0, 0), b2, voffB);
            PG8_BAR; PG8_WAIT_L(0); PG8_MMA(0, 1, At, B1); PG8_BAR;
            PG8_LDA(At, 0, 1); PG8_STAGE(PG8_SA(0, 0), a2, voffA);
            PG8_BAR; PG8_WAIT_L(0); PG8_MMA(1, 0, At, B0); PG8_BAR; PG8_SCHED;
            PG8_STAGE(PG8_SB(0, 1), b2 + hstep, voffB);
            PG8_WAIT_V(6); PG8_BAR; PG8_MMA(1, 1, At, B1); PG8_BAR;
            PG8_LDB(B0, 1, 0); PG8_SCHED; PG8_LDA(At, 1, 0); PG8_STAGE(PG8_SA(0, 1), a2 + hstep, voffA);
            PG8_WAIT_L(8); PG8_BAR; PG8_WAIT_L(0); PG8_MMA(0, 0, At, B0); PG8_BAR; PG8_SCHED;
            PG8_LDB(B1, 1, 1); PG8_STAGE(PG8_SB(1, 0), b3, voffB);
            PG8_BAR; PG8_WAIT_L(0); PG8_MMA(0, 1, At, B1); PG8_BAR;
            PG8_LDA(At, 1, 1); PG8_STAGE(PG8_SA(1, 0), a3, voffA);
            PG8_BAR; PG8_WAIT_L(0); PG8_MMA(1, 0, At, B0); PG8_BAR; PG8_SCHED;
            PG8_STAGE(PG8_SB(1, 1), b3 + hstep, voffB);
            PG8_WAIT_V(6); PG8_BAR; PG8_MMA(1, 1, At, B1); PG8_BAR;
            }
        }
        if constexpr (ALIGN_EPI) { if (wr == 0) PG8_BAR; }
        if constexpr (!Epi::AFTER_DRAIN) { E(acc, cur, wr, wc, fr, fq); S.done(cur); }
        if (!has_next) break;
#pragma unroll
        for (int a = 0; a < 2; ++a)
#pragma unroll
            for (int b = 0; b < 2; ++b)
#pragma unroll
                for (int m = 0; m < 4; ++m)
#pragma unroll
                    for (int n = 0; n < 2; ++n) acc[a][b][m][n] = (f32x4){0.f, 0.f, 0.f, 0.f};
        cur = nxt; cA = nA; cB = nB; ++ui;
        if constexpr (ALIGN_EPI) { if (wr == 1) PG8_BAR; }
    }
    PG8_WAIT_V(0);
    if constexpr (!ALIGN_EPI) { if (wr == 0) PG8_BAR; }
    PG8_BAR;
    if constexpr (Epi::AFTER_DRAIN) { E.fused(acc, cur, wr, wc, fr, fq, lds, wid, lane); S.done(cur); }
#undef PG8_SA
#undef PG8_SB
#undef PG8_STAGE
#undef PG8_LDA
#undef PG8_LDB
#undef PG8_MMA
#undef PG8_WAIT_V
#undef PG8_WAIT_L
#undef PG8_BAR
#undef PG8_SCHED
}
}


namespace att {
#define ALAS __attribute__((address_space(3)))
typedef unsigned short bf16_t;
typedef short bf16x8 __attribute__((ext_vector_type(8)));
typedef short s16x4 __attribute__((ext_vector_type(4)));
typedef float f32x16 __attribute__((ext_vector_type(16)));
typedef float f32x2_t __attribute__((ext_vector_type(2)));
typedef __bf16 bf16x2_t __attribute__((ext_vector_type(2)));
typedef unsigned u32x4 __attribute__((ext_vector_type(4)));
typedef unsigned u32x2 __attribute__((ext_vector_type(2)));
constexpr int SEQ = 2048, PJ = 2304, OC = 1024;
constexpr int C_QSB = 0, C_KSB = 512, C_VSB = 1024, C_QSW = 1536, C_KSW = 2048, C_VSW = 2176;
constexpr float LOG2E = 1.4426950408889634f;
constexpr float QSCALE = 0.125f * LOG2E;
constexpr float SB_EXIT = 64.0f;
__device__ __forceinline__ int crow(int r, int hh) { return (r & 3) + 8 * (r >> 2) + 4 * hh; }
__device__ __forceinline__ unsigned cvtpk(float lo, float hi) { f32x2_t v = {lo, hi}; bf16x2_t b = __builtin_convertvector(v, bf16x2_t); return __builtin_bit_cast(unsigned, b); }
__device__ __forceinline__ s16x4 vtr(const ALAS char* p) { typedef short v4i16_t __attribute__((ext_vector_type(4))); return __builtin_bit_cast(s16x4, __builtin_amdgcn_ds_read_tr16_b64_v4i16((ALAS v4i16_t*)p)); }
__device__ __forceinline__ float xhalf(float v) { return __shfl_xor(v, 32); }

struct VRegs { u32x4 v[4]; };
__device__ __forceinline__ void v_load(VRegs& R, const bf16_t* vtile, int lane) {
#pragma unroll
    for (int i = 0; i < 4; ++i) { const int id = i * 64 + lane, key = id >> 3, c = id & 7; R.v[i] = *(const u32x4*)(vtile + (size_t)key * PJ + c * 8); }
}
__device__ __forceinline__ void v_store(const VRegs& R, ALAS char* vl, int lane) {
#pragma unroll
    for (int i = 0; i < 4; ++i) { const int id = i * 64 + lane, key = id >> 3, c = id & 7; *(ALAS u32x4*)(vl + (c >> 2) * 2048 + key * 64 + (c & 3) * 16) = R.v[i]; }
}
__device__ __forceinline__ void pv_tile(f32x16& o0, f32x16& o1, const float (&w)[16], const ALAS char* vl, int lane) {
    const int hh = lane >> 5;
    const ALAS char* vb = vl + ((lane >> 4) & 1) * 32 + (lane & 3) * 8 + (4 * hh + ((lane & 15) >> 2)) * 64;
    u32x4 p0, p1;
    p0.x = cvtpk(w[0], w[1]); p0.y = cvtpk(w[2], w[3]); p0.z = cvtpk(w[4], w[5]); p0.w = cvtpk(w[6], w[7]);
    p1.x = cvtpk(w[8], w[9]); p1.y = cvtpk(w[10], w[11]); p1.z = cvtpk(w[12], w[13]); p1.w = cvtpk(w[14], w[15]);
    const bf16x8 pf0 = __builtin_bit_cast(bf16x8, p0), pf1 = __builtin_bit_cast(bf16x8, p1);
#define ATT_VFR(dt, s) ({ const s16x4 lo_ = vtr(vb + (dt) * 2048 + (s) * 1024), hi_ = vtr(vb + (dt) * 2048 + (s) * 1024 + 512); (bf16x8){lo_[0], lo_[1], lo_[2], lo_[3], hi_[0], hi_[1], hi_[2], hi_[3]}; })
    o0 = __builtin_amdgcn_mfma_f32_32x32x16_bf16(ATT_VFR(0, 0), pf0, o0, 0, 0, 0);
    o1 = __builtin_amdgcn_mfma_f32_32x32x16_bf16(ATT_VFR(1, 0), pf0, o1, 0, 0, 0);
    o0 = __builtin_amdgcn_mfma_f32_32x32x16_bf16(ATT_VFR(0, 1), pf1, o0, 0, 0, 0);
    o1 = __builtin_amdgcn_mfma_f32_32x32x16_bf16(ATT_VFR(1, 1), pf1, o1, 0, 0, 0);
#undef ATT_VFR
}
__device__ __forceinline__ void load_frag(bf16x8 (&f)[4], const bf16_t* p) {
#pragma unroll
    for (int d0 = 0; d0 < 4; ++d0) f[d0] = *(const bf16x8*)(p + 16 * d0);
}
__device__ __forceinline__ f32x16 qk_tile(const bf16x8 (&kf)[4], const bf16x8 (&qr)[4]) {
    f32x16 s = {};
#pragma unroll
    for (int d0 = 0; d0 < 4; ++d0) s = __builtin_amdgcn_mfma_f32_32x32x16_bf16(kf[d0], qr[d0], s, 0, 0, 0);
    return s;
}

__device__ __forceinline__ void sb_item(const bf16_t* proj, int b, int h, int qt, ALAS char* vl, f32x16& o0, f32x16& o1, int lane) {
    const int ql = lane & 31, hh = lane >> 5; const size_t rowb = (size_t)b * SEQ;
    bf16x8 qr[4]; load_frag(qr, proj + (rowb + 32 * qt + ql) * PJ + C_QSB + h * 64 + hh * 8);
    o0 = f32x16{}; o1 = f32x16{}; float R = 0.f;
    for (int kt = qt; kt >= 0; --kt) {
        bf16x8 kf[4]; load_frag(kf, proj + (rowb + 32 * kt + ql) * PJ + C_KSB + h * 64 + hh * 8);
        VRegs vr; v_load(vr, proj + (rowb + 32 * kt) * PJ + C_VSB + h * 64, lane);
        const f32x16 s = qk_tile(kf, qr);
        const bool diag = (kt == qt);
        float sp[16];
#pragma unroll
        for (int r = 0; r < 16; ++r) { const float z = s[r]; const float e = __builtin_amdgcn_exp2f(-__builtin_fabsf(z)); float v = __builtin_fmaxf(z, 0.f) + __builtin_amdgcn_logf(1.0f + e);
            if (diag && crow(r, hh) >= ql) v = 0.f; sp[r] = v; }
        float g[4], pg[4];
#pragma unroll
        for (int i = 0; i < 4; ++i) { g[i] = (sp[4 * i] + sp[4 * i + 1]) + (sp[4 * i + 2] + sp[4 * i + 3]); pg[i] = xhalf(g[i]); }
        const float T1 = g[1] + pg[1], T2 = g[2] + pg[2], T3 = g[3] + pg[3], T0 = g[0] + pg[0];
        float off[4]; off[3] = 0.f; off[2] = T3; off[1] = T3 + T2; off[0] = (T3 + T2) + T1;
        const float tot = off[0] + T0;
        float w[16];
#pragma unroll
        for (int i = 0; i < 4; ++i) { float c = R + off[i] + (hh == 0 ? pg[i] : 0.f);
#pragma unroll
            for (int j = 3; j >= 0; --j) { c += sp[4 * i + j]; float wv = __builtin_amdgcn_exp2f(s[4 * i + j] - c); if (diag && crow(4 * i + j, hh) >= ql) wv = 0.f; w[4 * i + j] = wv; } }
        R += tot;
        v_store(vr, vl, lane);
        pv_tile(o0, o1, w, vl, lane);
        if (__all(R > SB_EXIT)) break;
    }
}
__device__ __forceinline__ void swa_item(const bf16_t* proj, int b, int hq, int qt, ALAS char* vl, const ALAS float* tb, float sink2, f32x16& o0, f32x16& o1, int lane) {
    const int ql = lane & 31, hh = lane >> 5, kvh = hq >> 2; const size_t rowb = (size_t)b * SEQ;
    bf16x8 qr[4]; load_frag(qr, proj + (rowb + 32 * qt + ql) * PJ + C_QSW + hq * 64 + hh * 8);
    o0 = f32x16{}; o1 = f32x16{}; float m = sink2, l = 1.0f;
    for (int kt = (qt > 4 ? qt - 4 : 0); kt <= qt; ++kt) {
        bf16x8 kf[4]; load_frag(kf, proj + (rowb + 32 * kt + ql) * PJ + C_KSW + kvh * 64 + hh * 8);
        VRegs vr; v_load(vr, proj + (rowb + 32 * kt) * PJ + C_VSW + kvh * 64, lane);
        const f32x16 s = qk_tile(kf, qr);
        const int dbase = 32 * (qt - kt) + ql;
        float sc[16]; float mx = -1e30f;
#pragma unroll
        for (int r = 0; r < 16; ++r) { const int dist = dbase - crow(r, hh); const bool ok = (dist >= 0) && (dist < 128); const int idx = dist < 0 ? 0 : (dist > 127 ? 127 : dist);
            const float v = ok ? s[r] + tb[idx] : -1e30f; sc[r] = v; mx = __builtin_fmaxf(mx, v); }
        mx = __builtin_fmaxf(mx, xhalf(mx));
        const float mn = __builtin_fmaxf(m, mx), alpha = __builtin_amdgcn_exp2f(m - mn); m = mn;
        float w[16]; float ls = 0.f;
#pragma unroll
        for (int r = 0; r < 16; ++r) { w[r] = __builtin_amdgcn_exp2f(sc[r] - mn); ls += w[r]; }
        ls += xhalf(ls); l = l * alpha + ls;
        o0 *= alpha; o1 *= alpha;
        v_store(vr, vl, lane);
        pv_tile(o0, o1, w, vl, lane);
    }
    const float rl = 1.0f / l; o0 *= rl; o1 *= rl;
}
__device__ __forceinline__ void norm_store(f32x16& o0, f32x16& o1, bf16_t* ocat, int b, int qt, int colh, ALAS char* vl, ALAS float* ssb, int wid, int lane) {
    const int ql = lane & 31, hh = lane >> 5;
    float ss = 0.f;
#pragma unroll
    for (int r = 0; r < 16; ++r) ss += o0[r] * o0[r] + o1[r] * o1[r];
    ss += xhalf(ss);
    if (hh == 0) ssb[wid * 32 + ql] = ss;
    asm volatile("s_waitcnt lgkmcnt(0)" ::: "memory"); __builtin_amdgcn_s_barrier(); asm volatile("" ::: "memory");
    float tot = 0.f;
#pragma unroll
    for (int w8 = 0; w8 < 8; ++w8) tot += ssb[w8 * 32 + ql];
    const float rs = __builtin_amdgcn_rsqf(tot * (1.0f / 512.0f) + 1e-6f);
#pragma unroll
    for (int dt = 0; dt < 2; ++dt)
#pragma unroll
        for (int i = 0; i < 4; ++i) { const f32x16& o = dt ? o1 : o0; u32x2 pk; pk.x = cvtpk(o[4 * i] * rs, o[4 * i + 1] * rs); pk.y = cvtpk(o[4 * i + 2] * rs, o[4 * i + 3] * rs);
            *(ALAS u32x2*)(vl + ql * 128 + (((4 * dt + i) ^ (ql & 7)) << 4) + hh * 8) = pk; }
    asm volatile("s_waitcnt lgkmcnt(0)" ::: "memory");
    bf16_t* orow = ocat + ((size_t)b * SEQ + 32 * qt) * OC + colh;
#pragma unroll
    for (int i = 0; i < 4; ++i) { const int id = i * 64 + lane, row = id >> 3, c = id & 7; const u32x4 v = *(const ALAS u32x4*)(vl + row * 128 + ((c ^ (row & 7)) << 4));
        *(u32x4*)(orow + (size_t)row * OC + c * 8) = v; }
    asm volatile("s_waitcnt lgkmcnt(0)" ::: "memory");
}
constexpr int L_V = 0, L_SS = 32768, L_TB = 34816, L_END = 38912;
__device__ __forceinline__ void attn_phase(ALAS char* lds, const bf16_t* proj, bf16_t* ocat, const float* sinks, const float* rel_bias, int vcu, int wid, int lane) {
    ALAS char* vl = lds + L_V + wid * 4096; ALAS float* ssb = (ALAS float*)(lds + L_SS); ALAS float* tb = (ALAS float*)(lds + L_TB) + wid * 128;
#pragma unroll
    for (int i = 0; i < 2; ++i) { const int d = i * 64 + lane; int bk = d;
        if (d >= 16) { bk = 16 + (int)(__builtin_amdgcn_logf((float)d * (1.0f / 16.0f)) * (16.0f / 3.0f)); bk = bk > 31 ? 31 : bk; }
        tb[d] = rel_bias[bk * 8 + wid] * LOG2E; }
    const float sink2 = sinks[wid] * LOG2E;
    asm volatile("s_waitcnt lgkmcnt(0)" ::: "memory");
    const int b = vcu >> 5, p = vcu & 31;
    f32x16 o0, o1;
#pragma unroll 1
    for (int it = 0; it < 4; ++it) {
        const int qt = (it & 1) ? 63 - p : p;
        if (it < 2) sb_item(proj, b, wid, qt, vl, o0, o1, lane); else swa_item(proj, b, wid, qt, vl, tb, sink2, o0, o1, lane);
        norm_store(o0, o1, ocat, b, qt, (it < 2 ? 0 : 512) + wid * 64, vl, ssb + (it & 1) * 256, wid, lane);
    }
}
#undef ALAS
}

constexpr int NWAVES = 8;
#ifndef MK_PER_PHASE
#define MK_PER_PHASE 0
#endif
constexpr int DEPTH = 2, BATCH = 8, SEQ = 2048, DM = 1024, M = BATCH * SEQ, DFF = 2816, NGU = 2 * DFF, NIN = 2304;
constexpr int N_PHASES = 2 + 7 * DEPTH;
constexpr size_t MiB = 1u << 20;
constexpr size_t WS_CTL = 0, CTL_ZERO_BYTES = 64 * 1024;
constexpr size_t WS_W = 1 * MiB;
constexpr size_t W_GU = (size_t)NGU * DM * 2, W_D = (size_t)DM * DFF * 2, W_IN = (size_t)NIN * DM * 2, W_OUT = (size_t)DM * DM * 2;
constexpr size_t WL_GU1 = 0, WL_D1 = WL_GU1 + W_GU, WL_IN = WL_D1 + W_D, WL_OUT = WL_IN + W_IN, WL_GU2 = WL_OUT + W_OUT, WL_D2 = WL_GU2 + W_GU, WL_SIZE = WL_D2 + W_D;
constexpr size_t WS_HB = WS_W + DEPTH * WL_SIZE;
constexpr size_t WS_ACT = WS_HB + (size_t)M * DM * 2;
constexpr size_t WS_OCAT = WS_ACT + (size_t)M * DFF * 2;
constexpr size_t WS_SSP = WS_OCAT + (size_t)M * DM * 2;
constexpr size_t WS_END = WS_SSP + (size_t)M * 16;
static_assert(WS_END <= 256 * MiB && WS_HB % 256 == 0 && WS_ACT % 256 == 0 && WS_OCAT % 256 == 0 && WS_SSP % 256 == 0, "d_ws map");
constexpr int CW_BAR = 1024;
constexpr int RING_OFF = 0, RING_BYTES = 131072, MISC_OFF = RING_BYTES + 320, LDS_BYTES = 147456;

#define GAS __attribute__((address_space(1)))
#define LAS __attribute__((address_space(3)))
typedef unsigned short bf16;
typedef unsigned v4u __attribute__((ext_vector_type(4)));
typedef float f32x4 __attribute__((ext_vector_type(4)));
#define LDS_WAIT() asm volatile("s_waitcnt lgkmcnt(0)" ::: "memory")
#define VM_WAIT() asm volatile("s_waitcnt vmcnt(0)" ::: "memory")
__device__ __forceinline__ unsigned f2bf(float f) { unsigned u = __builtin_bit_cast(unsigned, f); return (u + 0x7fffu + ((u >> 16) & 1u)) >> 16; }
__device__ __forceinline__ unsigned pk2(float lo, float hi) { return f2bf(lo) | (f2bf(hi) << 16); }
__device__ __forceinline__ float wave_sum(float v) {
#pragma unroll
    for (int o = 1; o < 64; o <<= 1) v += __shfl_xor(v, o);
    return v;
}

#define XB_TMO      128
#define XB_XCNT(j)  (256  + 64 * (j))
#define XB_XSUB(j)  (1280 + 64 * (j))
#define XB_XGEN(j)  (2304 + 64 * (j))
#define XB_TOP      3328
#define XB_TOPGEN   3392
#define XCD_BAR_WORDS 3456
#define XB_SPIN_CAP (1u << 18)

__device__ __forceinline__ unsigned xb_ld(unsigned* p)              { return __hip_atomic_load(p, __ATOMIC_RELAXED, __HIP_MEMORY_SCOPE_AGENT); }
__device__ __forceinline__ unsigned xb_add(unsigned* p, unsigned v) { return __hip_atomic_fetch_add(p, v, __ATOMIC_RELAXED, __HIP_MEMORY_SCOPE_AGENT); }
__device__ __forceinline__ unsigned xb_xcc_id() { return (unsigned)__builtin_amdgcn_s_getreg((3 << 11) | 20) & 0xFu; }
#define XB_SPIN(cond, bar) do { unsigned _sp = 0; while (cond) { __builtin_amdgcn_s_sleep(1); \
    if ((++_sp & 255u) == 0u) { if (xb_ld(&(bar)[XB_TMO])) break; if (_sp > XB_SPIN_CAP) { atomicAdd(&(bar)[XB_TMO], 1u); break; } } } } while (0)

struct XcdBarrier {
    unsigned* bar; unsigned x;
    volatile LAS unsigned* st;
};

__device__ __forceinline__ XcdBarrier xcd_barrier_post(unsigned* bar, volatile LAS unsigned* st) {
    XcdBarrier b; b.bar = bar; b.x = xb_xcc_id(); b.st = st;
    if (threadIdx.x == 0) (void)xb_add(&bar[XB_XCNT(b.x)], 1u);
    return b;
}
__device__ __forceinline__ void xcd_barrier_complete(unsigned* bar, unsigned x, unsigned& nloc, unsigned& nx) {
    const unsigned G = gridDim.x * gridDim.y * gridDim.z;
    unsigned sum, cnt, mine, sp = 0u;
    for (;;) {
        sum = 0u; cnt = 0u; mine = 0u;
#pragma unroll
        for (unsigned j = 0; j < 16; ++j) { const unsigned c = xb_ld(&bar[XB_XCNT(j)]); sum += c; cnt += (c > 0u) ? 1u : 0u; mine = (j == x) ? c : mine; }
        if (sum == G) break;
        __builtin_amdgcn_s_sleep(1);
        if ((++sp & 255u) == 0u) { if (xb_ld(&bar[XB_TMO])) break; if (sp > XB_SPIN_CAP) { atomicAdd(&bar[XB_TMO], 1u); break; } }
    }
    nloc = mine > 0u ? mine : 1u; nx = cnt > 0u ? cnt : 1u;
}

__device__ __forceinline__ void xcd_barrier(const XcdBarrier& b) {
    asm volatile("s_waitcnt vmcnt(0)" ::: "memory");
    __syncthreads();
    if (threadIdx.x == 0) {
        unsigned* bar = b.bar;
        __builtin_amdgcn_s_waitcnt(0);
        unsigned nloc = b.st[0], nx = b.st[1];
        if (nloc == 0u) { xcd_barrier_complete(bar, b.x, nloc, nx); b.st[0] = nloc; b.st[1] = nx; }
        const unsigned old = xb_add(&bar[XB_XSUB(b.x)], 1u);
        const unsigned gen = old / nloc;
        if (old + 1u == (gen + 1u) * nloc) {
            __builtin_amdgcn_fence(__ATOMIC_RELEASE, "agent");
            asm volatile("s_waitcnt vmcnt(0)" ::: "memory");
            const unsigned og = xb_add(&bar[XB_TOP], 1u);
            const unsigned tg = og / nx;
            if (og + 1u == (tg + 1u) * nx) xb_add(&bar[XB_TOPGEN], 1u);
            else XB_SPIN(xb_ld(&bar[XB_TOPGEN]) == tg, bar);
            __builtin_amdgcn_fence(__ATOMIC_ACQUIRE, "agent");
            xb_add(&bar[XB_XGEN(b.x)], 1u);
            asm volatile("s_waitcnt vmcnt(0)" ::: "memory");
        } else {
            XB_SPIN(xb_ld(&bar[XB_XGEN(b.x)]) == gen, bar);
            __builtin_amdgcn_fence(__ATOMIC_ACQUIRE, "agent");
            asm volatile("s_waitcnt vmcnt(0)" ::: "memory");
        }
    }
    __syncthreads();
}


__device__ __forceinline__ void p0_item(const float* W, int ldw, int src_col0, const float* gain, bf16* WT, int K, int dst_row0, int k0, LAS float* scr, int lane) {
#pragma unroll
    for (int i = 0; i < 8; ++i) { const int kk = i * 8 + (lane >> 3), c4 = (lane & 7) * 4; f32x4 v = *(const f32x4*)(W + (size_t)(k0 + kk) * ldw + src_col0 + c4);
        if (gain) v = v * gain[k0 + kk];
        LAS float* s = scr + kk * 33 + c4; s[0] = v[0]; s[1] = v[1]; s[2] = v[2]; s[3] = v[3]; }
    LDS_WAIT(); asm volatile("" ::: "memory");
    const int c = lane & 7;
#pragma unroll
    for (int j = 0; j < 4; ++j) { const int n = (lane >> 3) + 8 * j; const LAS float* s = scr + (8 * c) * 33 + n;
        v4u o; o.x = pk2(s[0 * 33], s[1 * 33]); o.y = pk2(s[2 * 33], s[3 * 33]); o.z = pk2(s[4 * 33], s[5 * 33]); o.w = pk2(s[6 * 33], s[7 * 33]);
        *(v4u*)(WT + (size_t)(dst_row0 + n) * K + k0 + 8 * c) = o; }
    LDS_WAIT(); asm volatile("" ::: "memory");
}
struct Args { const float* in[15]; float* out; unsigned char* ws; int ph_lo, ph_hi; };
__device__ __forceinline__ void p0_weights(const Args& a, LAS float* scr, int gw, int ngw, int lane) {
    constexpr int I_GU = (DM / 64) * (NGU / 32), I_D = (DFF / 64) * (DM / 32), I_IN = (DM / 64) * (NIN / 32), I_OUT = (DM / 64) * (DM / 32);
    constexpr int I_LAYER = 2 * I_GU + 2 * I_D + I_IN + I_OUT;
    for (int it = gw; it < DEPTH * I_LAYER; it += ngw) {
        const int l = it / I_LAYER; int r = it % I_LAYER;
        bf16* wl = (bf16*)(a.ws + WS_W + (size_t)l * WL_SIZE);
        if (r < 2 * I_GU) {
            const int f = r / I_GU; r %= I_GU; const int nb = r % (NGU / 32), kb = r / (NGU / 32), n0 = nb * 32, t = n0 >> 8, j = n0 & 255;
            const int src = (j < 128) ? (128 * t + j) : (DFF + 128 * t + (j - 128));
            p0_item(a.in[f ? 11 : 2] + (size_t)l * DM * NGU, NGU, src, a.in[f ? 10 : 1] + l * DM, (bf16*)((char*)wl + (f ? WL_GU2 : WL_GU1)), DM, n0, kb * 64, scr, lane); continue; }
        r -= 2 * I_GU;
        if (r < 2 * I_D) { const int f = r / I_D; r %= I_D; const int nb = r % (DM / 32), kb = r / (DM / 32);
            p0_item(a.in[f ? 12 : 3] + (size_t)l * DFF * DM, DM, nb * 32, nullptr, (bf16*)((char*)wl + (f ? WL_D2 : WL_D1)), DFF, nb * 32, kb * 64, scr, lane); continue; }
        r -= 2 * I_D;
        if (r < I_IN) { const int nb = r % (NIN / 32), kb = r / (NIN / 32);
            p0_item(a.in[5] + (size_t)l * DM * NIN, NIN, nb * 32, a.in[4] + l * DM, (bf16*)((char*)wl + WL_IN), DM, nb * 32, kb * 64, scr, lane); continue; }
        r -= I_IN;
        { const int nb = r % (DM / 32), kb = r / (DM / 32), k0 = kb * 64;
          const float* gain = (k0 < 512) ? (a.in[7] + l * 512 + k0) - k0 : (a.in[8] + l * 512 + (k0 - 512)) - k0;
          p0_item(a.in[9] + (size_t)l * DM * DM, DM, nb * 32, gain, (bf16*)((char*)wl + WL_OUT), DM, nb * 32, k0, scr, lane); }
    }
}
__device__ __forceinline__ void p0_rows(const float* x, bf16* hb, float* ssp, int gw, int ngw, int lane) {
    for (int m = gw; m < M; m += ngw) {
        const f32x4* xr = (const f32x4*)(x + (size_t)m * DM) + lane; f32x4 v[4]; float s = 0.f;
#pragma unroll
        for (int j = 0; j < 4; ++j) { v[j] = xr[64 * j]; s += (v[j][0] * v[j][0] + v[j][1] * v[j][1]) + (v[j][2] * v[j][2] + v[j][3] * v[j][3]); }
        s = wave_sum(s);
        unsigned long long* o8 = (unsigned long long*)(hb + (size_t)m * DM) + lane;
#pragma unroll
        for (int j = 0; j < 4; ++j) o8[64 * j] = (unsigned long long)pk2(v[j][0], v[j][1]) | ((unsigned long long)pk2(v[j][2], v[j][3]) << 32);
        if (lane == 0) *(f32x4*)(ssp + 4 * (size_t)m) = (f32x4){s, 0.f, 0.f, 0.f};
    }
}
__device__ __forceinline__ void final_rows(float* h, const float* ssp, const float* gain, int gw, int ngw, int lane) {
    f32x4 gv[4];
#pragma unroll
    for (int j = 0; j < 4; ++j) gv[j] = ((const f32x4*)gain)[lane + 64 * j];
    for (int m = gw; m < M; m += ngw) {
        const f32x4 p = *(const f32x4*)(ssp + 4 * (size_t)m); const float rs = __builtin_amdgcn_rsqf(((p[0] + p[1]) + (p[2] + p[3])) * (1.0f / DM) + 1e-6f);
        f32x4* hr = (f32x4*)(h + (size_t)m * DM) + lane;
#pragma unroll
        for (int j = 0; j < 4; ++j) { const f32x4 v = hr[64 * j]; hr[64 * j] = v * rs * gv[j]; }
    }
}

__global__ void __launch_bounds__(NWAVES * 64, 2) hymba_fwd(Args args) {
    extern __shared__ __attribute__((aligned(16))) unsigned char lds_raw[];
    LAS unsigned char* lds = (LAS unsigned char*)lds_raw;
    volatile LAS unsigned* MISC = (volatile LAS unsigned*)(lds + MISC_OFF);
    const int tid = threadIdx.x, lane = tid & 63, wave = __builtin_amdgcn_readfirstlane(tid >> 6);
    const int G = gridDim.x, bx = blockIdx.x, vcu = (G % 8 == 0) ? (bx % 8) * (G / 8) + bx / 8 : bx;
    unsigned char* ws = args.ws;
    for (int u = tid; u < (LDS_BYTES - RING_BYTES) / 4; u += NWAVES * 64) ((LAS unsigned*)(lds + RING_BYTES))[u] = 0u;
    __syncthreads();
    XcdBarrier bar; bar.bar = (unsigned*)(ws + WS_CTL) + CW_BAR; bar.x = 0; bar.st = nullptr;
    if (!MK_PER_PHASE) bar = xcd_barrier_post((unsigned*)(ws + WS_CTL) + CW_BAR, MISC + 8);
    const int lo = args.ph_lo, hi = args.ph_hi;
#define IN(k) (lo <= (k) && (k) < hi)
#define SEAM(k) do { if (IN(k) && IN((k) + 1)) xcd_barrier(bar); } while (0)
    float* h = args.out;
    bf16* hb = (bf16*)(ws + WS_HB); bf16* act = (bf16*)(ws + WS_ACT); bf16* proj = (bf16*)(ws + WS_ACT); bf16* ocat = (bf16*)(ws + WS_OCAT); float* ssp = (float*)(ws + WS_SSP);
    const int gw = vcu * NWAVES + wave, ngw = G * NWAVES;

    if (IN(0)) { p0_weights(args, (LAS float*)(lds + RING_OFF + wave * 16384), gw, ngw, lane); p0_rows(args.in[0], hb, ssp, gw, ngw, lane); SEAM(0); }

#pragma unroll 1
    for (int l = 0; l < DEPTH; ++l) {
        const int pb = 1 + 7 * l;
        const pg8::bf16_t* wl = (const pg8::bf16_t*)(ws + WS_W + (size_t)l * WL_SIZE);
#pragma unroll 1
        for (int f = 0; f < 2; ++f) {
            const int pf = pb + (f ? 5 : 0);
            if (IN(pf)) {
                pg8::Gemm g{hb, (const pg8::bf16_t*)((const char*)wl + (f ? WL_GU2 : WL_GU1)), M, NGU, DM}; pg8::StaticOrder S; S.init(M, NGU, G, bx);
                pg8::EpiSwiGLU E{act, DFF, ssp};
                pg8::gemm_phase<pg8::EpiSwiGLU, pg8::StaticOrder, true, true>(lds + RING_OFF, g, S, E);
                SEAM(pf);
            }
            if (IN(pf + 1)) {
                pg8::Gemm g{act, (const pg8::bf16_t*)((const char*)wl + (f ? WL_D2 : WL_D1)), M, DM, DFF}; pg8::StaticOrder S; S.init(M, DM, G, bx);
                pg8::EpiRes E{(l == 0 && f == 0) ? args.in[0] : h, h, hb, ssp, 0.5f};
                pg8::gemm_phase<pg8::EpiRes, pg8::StaticOrder, false, true>(lds + RING_OFF, g, S, E);
                SEAM(pf + 1);
            }
            if (f == 1) break;
            if (IN(pb + 2)) {
                pg8::Gemm g{hb, (const pg8::bf16_t*)((const char*)wl + WL_IN), M, NIN, DM}; pg8::StaticOrder S; S.init(M, NIN, G, bx);
                pg8::EpiProj E{proj, NIN, ssp, 0xC3u, att::QSCALE};
                pg8::gemm_phase<pg8::EpiProj, pg8::StaticOrder, true, true>(lds + RING_OFF, g, S, E);
                SEAM(pb + 2);
            }
            if (IN(pb + 3)) {
                int t_ = threadIdx.x; asm volatile("" : "+v"(t_));
                att::attn_phase((LAS char*)(lds + RING_OFF), proj, ocat, args.in[6] + l * 8, args.in[13], vcu, __builtin_amdgcn_readfirstlane(t_ >> 6), t_ & 63);
                SEAM(pb + 3);
            }
            if (IN(pb + 4)) {
                pg8::Gemm g{ocat, (const pg8::bf16_t*)((const char*)wl + WL_OUT), M, DM, DM}; pg8::StaticOrder S; S.init(M, DM, G, bx);
                pg8::EpiRes E{h, h, hb, ssp, 1.0f};
                pg8::gemm_phase<pg8::EpiRes, pg8::StaticOrder, false, true>(lds + RING_OFF, g, S, E);
                SEAM(pb + 4);
            }
        }
    }
    if (IN(N_PHASES - 1)) final_rows(h, ssp, args.in[14], gw, ngw, lane);
#undef IN
#undef SEAM
}

extern "C" void kernel_launch(void* const* d_in, const int* in_sizes, int n_in, void* d_out, int out_size, void* d_ws, size_t ws_size, hipStream_t stream) {
    static int grid = 0;
    if (grid == 0) {
        if (n_in != 15 || in_sizes[0] != M * DM || out_size != M * DM || ws_size < WS_END) { fprintf(stderr, "kernel_launch: unexpected shapes (n_in %d, x %d, out %d, ws %zu); nothing launched\n", n_in, n_in > 0 ? in_sizes[0] : -1, out_size, ws_size); grid = -1; return; }
        int dev = 0, cus = 0, per_cu = 0;
        if (hipGetDevice(&dev) != hipSuccess || hipDeviceGetAttribute(&cus, hipDeviceAttributeMultiprocessorCount, dev) != hipSuccess) { grid = -1; return; }
        if (hipFuncSetAttribute((const void*)hymba_fwd, hipFuncAttributeMaxDynamicSharedMemorySize, LDS_BYTES) != hipSuccess) { fprintf(stderr, "kernel_launch: hipFuncSetAttribute failed\n"); grid = -1; return; }
        if (hipOccupancyMaxActiveBlocksPerMultiprocessor(&per_cu, (const void*)hymba_fwd, NWAVES * 64, LDS_BYTES) != hipSuccess || per_cu < 1) { fprintf(stderr, "kernel_launch: occupancy query says %d blocks per CU\n", per_cu); per_cu = 1; }
        (void)hipGetLastError();
        grid = cus;
        if (grid != 256) fprintf(stderr, "kernel_launch: %d CUs; this kernel is laid out for 256 (one 256x256 unit per workgroup in the N = 1024 GEMM phases)\n", grid);
    }
    if (grid < 0) return;
    Args a{};
    for (int i = 0; i < 15; ++i) a.in[i] = (const float*)d_in[i];
    a.out = (float*)d_out; a.ws = (unsigned char*)d_ws;
#if MK_PER_PHASE
    for (int p = 0; p < N_PHASES; ++p) { a.ph_lo = p; a.ph_hi = p + 1; hipLaunchKernelGGL(hymba_fwd, dim3(grid), dim3(NWAVES * 64), LDS_BYTES, stream, a); }
#else
    (void)hipMemsetAsync((char*)d_ws + WS_CTL, 0, CTL_ZERO_BYTES, stream);
    a.ph_lo = 0; a.ph_hi = N_PHASES;
    void* kargs[] = {&a};
    hipError_t e = hipLaunchCooperativeKernel((const void*)hymba_fwd, dim3(grid), dim3(NWAVES * 64), kargs, LDS_BYTES, stream);
    if (e != hipSuccess) fprintf(stderr, "kernel_launch: cooperative launch failed: %s (grid %d)\n", hipGetErrorString(e), grid);
#endif
}
```

```cpp
#include <hip/hip_runtime.h>
#include <cstdio>
#include <cstdint>

namespace pg8 {
#define PG8_LAS __attribute__((address_space(3)))
typedef unsigned short bf16_t;
typedef short bf16x8 __attribute__((ext_vector_type(8)));
typedef float f32x4 __attribute__((ext_vector_type(4)));
typedef unsigned u32x4 __attribute__((ext_vector_type(4)));
constexpr int BM = 256, BK = 64, HALF = 128, HTB = HALF * BK * 2  , STAGE_BYTES = 8 * HTB, NXCD = 8, WGM = 8;

__host__ __device__ __forceinline__ int lds_byte(int r, int c) { const int st = (r >> 4) * 2 + (c >> 5), rr = r & 15, cc = c & 31, ob = rr * 64 + cc * 2; return st * 1024 + (ob ^ (((ob >> 9) & 1) << 5)); }
__host__ __device__ __forceinline__ void stage_rc(int b, int& R, int& C) { const int st = b / 1024, sb = b % 1024, swz = sb ^ (((sb >> 9) & 1) << 5); R = (st >> 1) * 16 + swz / 64; C = (st & 1) * 32 + (swz % 64) / 2; }
__host__ __device__ __forceinline__ int perm32(int rho) { const int n = rho >> 4, i = rho & 15; return 8 * (i >> 2) + 4 * n + (i & 3); }

struct Unit { int pm, pn; };
struct Gemm { const bf16_t* A; const bf16_t* Bt; int M, N, K; };

struct StaticOrder {
    int nM, nN, nwg, G, c;
    __host__ __device__ void init(int M, int N, int G_, int c_) { nM = M / BM; nN = N / BM; nwg = nM * nN; G = G_; c = c_; }
    __host__ __device__ bool next(int i, Unit& u) const {
        const long L = (long)i * G + c; if (L >= nwg) return false;
        int wgid = (int)L; { const int q = nwg / NXCD, r = nwg % NXCD, xcd = wgid % NXCD, off = wgid / NXCD; wgid = (xcd < r ? xcd * (q + 1) : r * (q + 1) + (xcd - r) * q) + off; }
        const int nig = WGM * nN, gid = wgid / nig, fm = gid * WGM, gsz = (nM - fm) < WGM ? (nM - fm) : WGM;
        u.pm = fm + ((wgid % nig) % gsz); u.pn = (wgid % nig) / gsz; return true;
    }
    __device__ __forceinline__ void a_ready(const Unit&) const {}
    __device__ __forceinline__ void done(const Unit&) const {}
};

__device__ __forceinline__ unsigned cvt_pk_bf16(float lo, float hi) { unsigned r; asm volatile("v_cvt_pk_bf16_f32 %0, %1, %2" : "=v"(r) : "v"(lo), "v"(hi)); return r; }
constexpr float RMS_EPS = 1e-6f;
__device__ __forceinline__ float row_rstd(const float* ssp, int row, float inv_n) { const f32x4 p = *(const f32x4*)(ssp + 4 * (size_t)row); return __builtin_amdgcn_rsqf(((p[0] + p[1]) + (p[2] + p[3])) * inv_n + RMS_EPS); }
__device__ __forceinline__ float silu_mul(float g, float u) { const float e = __builtin_amdgcn_exp2f(g * -1.4426950408889634f); return g * __builtin_amdgcn_rcpf(1.0f + e) * u; }

struct EpiSwiGLU {
    static constexpr bool PERM = true, AFTER_DRAIN = false;
    bf16_t* O; int ldc; const float* ssp;
    __device__ __forceinline__ void operator()(const f32x4 (&acc)[2][2][4][2], const Unit& u, int wr, int wc, int fr, int fq) const {
        const int row0 = u.pm * BM + wr * 64 + fr, col0 = u.pn * HALF + wc * 32 + 8 * fq;
#pragma unroll
        for (int ai = 0; ai < 2; ++ai)
#pragma unroll
            for (int m = 0; m < 4; ++m) { const int row = row0 + ai * HALF + m * 16; const float rs = row_rstd(ssp, row, 1.0f / 1024.0f);
                const f32x4 g0 = acc[ai][0][m][0] * rs, g1 = acc[ai][0][m][1] * rs, u0 = acc[ai][1][m][0] * rs, u1 = acc[ai][1][m][1] * rs;
                u32x4 w; w.x = cvt_pk_bf16(silu_mul(g0[0], u0[0]), silu_mul(g0[1], u0[1])); w.y = cvt_pk_bf16(silu_mul(g0[2], u0[2]), silu_mul(g0[3], u0[3]));
                w.z = cvt_pk_bf16(silu_mul(g1[0], u1[0]), silu_mul(g1[1], u1[1])); w.w = cvt_pk_bf16(silu_mul(g1[2], u1[2]), silu_mul(g1[3], u1[3]));
                *(u32x4*)(O + (size_t)row * ldc + col0) = w; }
    }
};
struct EpiProj {
    static constexpr bool PERM = true, AFTER_DRAIN = false;
    bf16_t* O; int ldc; const float* ssp; unsigned qmask; float qscale;
    __device__ __forceinline__ void operator()(const f32x4 (&acc)[2][2][4][2], const Unit& u, int wr, int wc, int fr, int fq) const {
        const int row0 = u.pm * BM + wr * 64 + fr, col0 = u.pn * BM + wc * 32 + 8 * fq;
        const float sc = ((qmask >> u.pn) & 1u) ? qscale : 1.0f;
#pragma unroll
        for (int ai = 0; ai < 2; ++ai)
#pragma unroll
            for (int m = 0; m < 4; ++m) { const int row = row0 + ai * HALF + m * 16; const float rs = row_rstd(ssp, row, 1.0f / 1024.0f) * sc;
#pragma unroll
                for (int bj = 0; bj < 2; ++bj) { const f32x4 v0 = acc[ai][bj][m][0] * rs, v1 = acc[ai][bj][m][1] * rs;
                    u32x4 w; w.x = cvt_pk_bf16(v0[0], v0[1]); w.y = cvt_pk_bf16(v0[2], v0[3]); w.z = cvt_pk_bf16(v1[0], v1[1]); w.w = cvt_pk_bf16(v1[2], v1[3]);
                    *(u32x4*)(O + (size_t)row * ldc + col0 + bj * HALF) = w; } }
    }
};
template <bool F32OUT> struct EpiRes {
    static constexpr bool PERM = true, AFTER_DRAIN = true;
    float* out; bf16_t* hb; float* ssp; float alpha;
    __device__ __forceinline__ void fused(f32x4 (&acc)[2][2][4][2], const Unit& u, int wr, int wc, int fr, int fq, PG8_LAS unsigned char* lds, int wid, int lane) const {
        PG8_LAS float* P = (PG8_LAS float*)lds;
        const int col0 = u.pn * BM + wc * 32 + 8 * fq;
#pragma unroll
        for (int ai = 0; ai < 2; ++ai)
#pragma unroll
            for (int m = 0; m < 4; ++m) { const int rl = ai * HALF + wr * 64 + m * 16 + fr; const size_t off = (size_t)(u.pm * BM + rl) * 1024 + col0; float s = 0.f;
#pragma unroll
                for (int bj = 0; bj < 2; ++bj) { const u32x4 b = *(const u32x4*)(hb + off + bj * HALF);
                    f32x4 v0, v1;
                    v0[0] = __uint_as_float(b.x << 16); v0[1] = __uint_as_float(b.x & 0xffff0000u); v0[2] = __uint_as_float(b.y << 16); v0[3] = __uint_as_float(b.y & 0xffff0000u);
                    v1[0] = __uint_as_float(b.z << 16); v1[1] = __uint_as_float(b.z & 0xffff0000u); v1[2] = __uint_as_float(b.w << 16); v1[3] = __uint_as_float(b.w & 0xffff0000u);
                    v0 = v0 + acc[ai][bj][m][0] * alpha; v1 = v1 + acc[ai][bj][m][1] * alpha;
                    if (F32OUT) { *(f32x4*)(out + off + bj * HALF) = v0; *(f32x4*)(out + off + bj * HALF + 4) = v1; }
                    else { u32x4 w; w.x = cvt_pk_bf16(v0[0], v0[1]); w.y = cvt_pk_bf16(v0[2], v0[3]); w.z = cvt_pk_bf16(v1[0], v1[1]); w.w = cvt_pk_bf16(v1[2], v1[3]);
                        *(u32x4*)(hb + off + bj * HALF) = w; }
                    s += (v0[0] * v0[0] + v0[1] * v0[1]) + (v0[2] * v0[2] + v0[3] * v0[3]) + (v1[0] * v1[0] + v1[1] * v1[1]) + (v1[2] * v1[2] + v1[3] * v1[3]); }
                s += __shfl_xor(s, 16); s += __shfl_xor(s, 32);
                if (fq == 0) P[rl * 4 + wc] = s; }
        asm volatile("s_waitcnt lgkmcnt(0)" ::: "memory"); __builtin_amdgcn_s_barrier(); asm volatile("" ::: "memory");
        const int t = wid * 64 + lane;
        if (t < 256) { const f32x4 p = *(const PG8_LAS f32x4*)(P + t * 4); ssp[(size_t)(u.pm * BM + t) * 4 + u.pn] = (p[0] + p[1]) + (p[2] + p[3]); }
        asm volatile("s_waitcnt lgkmcnt(0)" ::: "memory"); __builtin_amdgcn_s_barrier(); asm volatile("" ::: "memory");
    }
};

template <class Epi, class Sched, bool ALIGN_EPI = false, bool SP2 = false>
__device__ __forceinline__ void gemm_phase(PG8_LAS unsigned char* lds, const Gemm g, const Sched& S, const Epi& E) {
    int tid_ = threadIdx.x; asm volatile("" : "+v"(tid_));
    const int tid = tid_, wid = __builtin_amdgcn_readfirstlane(tid >> 6), lane = tid & 63, wr = wid >> 2, wc = wid & 3, fr = lane & 15, fq = lane >> 4;
    const int K = g.K, nt = K / BK;
    unsigned voffA[2], voffB[2];
#pragma unroll
    for (int i = 0; i < 2; ++i) { int R, C; stage_rc(tid * 16 + i * 8192, R, C); const int Rb = Epi::PERM ? ((R & ~31) + perm32(R & 31)) : R;
        voffA[i] = (unsigned)(R * K + C) * 2u; voffB[i] = (unsigned)(Rb * K + C) * 2u; }
    const size_t kstep = (size_t)(BK * 2);
    const size_t hstep = (size_t)HALF * K * 2;
    const size_t tstep = 2 * hstep;
    const unsigned ldsw = (unsigned)wid * 1024u;
    const int aoff = lds_byte(wr * 64 + fr, fq * 8), boff = lds_byte(wc * 32 + fr, fq * 8);
#define PG8_SA(b, h) (((b) * 2 + (h)) * HTB)
#define PG8_SB(b, h) ((4 + (b) * 2 + (h)) * HTB)
#define PG8_STAGE(bufoff, gbase, voff) do { _Pragma("unroll") for (int _i = 0; _i < 2; ++_i) \
        __builtin_amdgcn_global_load_lds((const unsigned*)((const char*)(gbase) + (voff)[_i]), (PG8_LAS unsigned*)(lds + (bufoff) + ldsw + _i * 8192), 16, 0, 0); } while (0)
#define PG8_LDA(dst, b, h) do { _Pragma("unroll") for (int m = 0; m < 4; ++m) _Pragma("unroll") for (int k = 0; k < 2; ++k) dst[m][k] = *(const PG8_LAS bf16x8*)(lds + PG8_SA(b, h) + aoff + m * 2048 + k * 1024); } while (0)
#define PG8_LDB(dst, b, h) do { _Pragma("unroll") for (int n = 0; n < 2; ++n) _Pragma("unroll") for (int k = 0; k < 2; ++k) dst[n][k] = *(const PG8_LAS bf16x8*)(lds + PG8_SB(b, h) + boff + n * 2048 + k * 1024); } while (0)
#define PG8_MMA(ai, bj, At, Bt) do { __builtin_amdgcn_s_setprio(1); _Pragma("unroll") for (int m = 0; m < 4; ++m) _Pragma("unroll") for (int n = 0; n < 2; ++n) _Pragma("unroll") for (int k = 0; k < 2; ++k) \
        acc[ai][bj][m][n] = __builtin_amdgcn_mfma_f32_16x16x32_bf16(Bt[n][k], At[m][k], acc[ai][bj][m][n], 0, 0, 0); __builtin_amdgcn_s_setprio(0); } while (0)
#define PG8_WAIT_V(n) asm volatile("s_waitcnt vmcnt(" #n ")" ::: "memory")
#define PG8_WAIT_L(n) asm volatile("s_waitcnt lgkmcnt(" #n ")" ::: "memory")
#define PG8_BAR __builtin_amdgcn_s_barrier()
#define PG8_SCHED __builtin_amdgcn_sched_barrier(0)
    Unit cur, nxt; int ui = 0;
    if (!S.next(0, cur)) return;
    f32x4 acc[2][2][4][2];
#pragma unroll
    for (int a = 0; a < 2; ++a)
#pragma unroll
        for (int b = 0; b < 2; ++b)
#pragma unroll
            for (int m = 0; m < 4; ++m)
#pragma unroll
                for (int n = 0; n < 2; ++n) acc[a][b][m][n] = (f32x4){0.f, 0.f, 0.f, 0.f};
    bf16x8 At[4][2], B0[2][2], B1[2][2];
    const char* cA = (const char*)g.A + (size_t)cur.pm * tstep; const char* cB = (const char*)g.Bt + (size_t)cur.pn * tstep;
    S.a_ready(cur);
    if constexpr (SP2) {
        PG8_STAGE(PG8_SB(0, 0), cB, voffB); PG8_STAGE(PG8_SB(0, 1), cB + hstep, voffB); PG8_STAGE(PG8_SA(0, 0), cA, voffA); PG8_STAGE(PG8_SA(0, 1), cA + hstep, voffA);
        if (wr == 1) PG8_BAR;
        PG8_WAIT_V(2); PG8_BAR;
        PG8_STAGE(PG8_SB(1, 0), cB + kstep, voffB); PG8_STAGE(PG8_SA(1, 0), cA + kstep, voffA); PG8_STAGE(PG8_SB(1, 1), cB + hstep + kstep, voffB);
        PG8_WAIT_V(6); PG8_BAR;
    } else {
        PG8_STAGE(PG8_SB(0, 0), cB, voffB); PG8_STAGE(PG8_SA(0, 0), cA, voffA); PG8_STAGE(PG8_SB(0, 1), cB + hstep, voffB); PG8_STAGE(PG8_SA(0, 1), cA + hstep, voffA);
        if (wr == 1) PG8_BAR;
        PG8_WAIT_V(4); PG8_BAR;
        PG8_STAGE(PG8_SB(1, 0), cB + kstep, voffB); PG8_STAGE(PG8_SA(1, 0), cA + kstep, voffA); PG8_STAGE(PG8_SB(1, 1), cB + hstep + kstep, voffB);
        PG8_WAIT_V(6); PG8_BAR;
    }
    for (;;) {
        const bool has_next = S.next(ui + 1, nxt);
        const char* nA = has_next ? (const char*)g.A + (size_t)nxt.pm * tstep : cA; const char* nB = has_next ? (const char*)g.Bt + (size_t)nxt.pn * tstep : cB;
        for (int t = 0; t < nt; t += 2) {
            const bool last = (t == nt - 2);
            const char* a1 = cA + (size_t)(t + 1) * kstep;
            const char* a2 = last ? nA : cA + (size_t)(t + 2) * kstep; const char* b2 = last ? nB : cB + (size_t)(t + 2) * kstep;
            const char* a3 = a2 + kstep; const char* b3 = b2 + kstep;
            if (last && has_next) S.a_ready(nxt);
            if constexpr (SP2) {
            PG8_LDB(B0, 0, 0); PG8_LDB(B1, 0, 1); PG8_SCHED; PG8_LDA(At, 0, 0); PG8_STAGE(PG8_SA(1, 1), a1 + hstep, voffA);
            PG8_WAIT_V(8); PG8_WAIT_L(0); PG8_BAR; PG8_MMA(0, 0, At, B0); PG8_MMA(0, 1, At, B1); PG8_BAR; PG8_SCHED;
            PG8_LDA(At, 0, 1); PG8_STAGE(PG8_SB(0, 0), b2, voffB); PG8_STAGE(PG8_SB(0, 1), b2 + hstep, voffB); PG8_STAGE(PG8_SA(0, 0), a2, voffA);
            PG8_WAIT_V(8); PG8_WAIT_L(0); PG8_BAR; PG8_MMA(1, 0, At, B0); PG8_MMA(1, 1, At, B1); PG8_BAR; PG8_SCHED;
            PG8_LDB(B0, 1, 0); PG8_LDB(B1, 1, 1); PG8_SCHED; PG8_LDA(At, 1, 0); PG8_STAGE(PG8_SA(0, 1), a2 + hstep, voffA);
            PG8_WAIT_V(8); PG8_WAIT_L(0); PG8_BAR; PG8_MMA(0, 0, At, B0); PG8_MMA(0, 1, At, B1); PG8_BAR; PG8_SCHED;
            PG8_LDA(At, 1, 1); PG8_STAGE(PG8_SB(1, 0), b3, voffB); PG8_STAGE(PG8_SB(1, 1), b3 + hstep, voffB); PG8_STAGE(PG8_SA(1, 0), a3, voffA);
            PG8_WAIT_V(8); PG8_WAIT_L(0); PG8_BAR; PG8_MMA(1, 0, At, B0); PG8_MMA(1, 1, At, B1); PG8_BAR; PG8_SCHED;
            } else {
            PG8_LDB(B0, 0, 0); PG8_SCHED; PG8_LDA(At, 0, 0); PG8_STAGE(PG8_SA(1, 1), a1 + hstep, voffA);
            PG8_WAIT_L(8); PG8_BAR; PG8_WAIT_L(0); PG8_MMA(0, 0, At, B0); PG8_BAR; PG8_SCHED;
            PG8_LDB(B1, 0, 1); PG8_STAGE(PG8_SB(0, 0), b2, voffB);
            PG8_BAR; PG8_WAIT_L(0); PG8_MMA(0, 1, At, B1); PG8_BAR;
            PG8_LDA(At, 0, 1); PG8_STAGE(PG8_SA(0, 0), a2, voffA);
            PG8_BAR; PG8_WAIT_L(0); PG8_MMA(1, 0, At, B0); PG8_BAR; PG8_SCHED;
            PG8_STAGE(PG8_SB(0, 1), b2 + hstep, voffB);
            PG8_WAIT_V(6); PG8_BAR; PG8_MMA(1, 1, At, B1); PG8_BAR;
            PG8_LDB(B0, 1, 0); PG8_SCHED; PG8_LDA(At, 1, 0); PG8_STAGE(PG8_SA(0, 1), a2 + hstep, voffA);
            PG8_WAIT_L(8); PG8_BAR; PG8_WAIT_L(0); PG8_MMA(0, 0, At, B0); PG8_BAR; PG8_SCHED;
            PG8_LDB(B1, 1, 1); PG8_STAGE(PG8_SB(1, 0), b3, voffB);
            PG8_BAR; PG8_WAIT_L(0); PG8_MMA(0, 1, At, B1); PG8_BAR;
            PG8_LDA(At, 1, 1); PG8_STAGE(PG8_SA(1, 0), a3, voffA);
            PG8_BAR; PG8_WAIT_L(0); PG8_MMA(1, 0, At, B0); PG8_BAR; PG8_SCHED;
            PG8_STAGE(PG8_SB(1, 1), b3 + hstep, voffB);
            PG8_WAIT_V(6); PG8_BAR; PG8_MMA(1, 1, At, B1); PG8_BAR;
            }
        }
        if constexpr (ALIGN_EPI) { if (wr == 0) PG8_BAR; }
        if constexpr (!Epi::AFTER_DRAIN) { E(acc, cur, wr, wc, fr, fq); S.done(cur); }
        if (!has_next) break;
#pragma unroll
        for (int a = 0; a < 2; ++a)
#pragma unroll
            for (int b = 0; b < 2; ++b)
#pragma unroll
                for (int m = 0; m < 4; ++m)
#pragma unroll
                    for (int n = 0; n < 2; ++n) acc[a][b][m][n] = (f32x4){0.f, 0.f, 0.f, 0.f};
        cur = nxt; cA = nA; cB = nB; ++ui;
        if constexpr (ALIGN_EPI) { if (wr == 1) PG8_BAR; }
    }
    PG8_WAIT_V(0);
    if constexpr (!ALIGN_EPI) { if (wr == 0) PG8_BAR; }
    PG8_BAR;
    if constexpr (Epi::AFTER_DRAIN) { E.fused(acc, cur, wr, wc, fr, fq, lds, wid, lane); S.done(cur); }
#undef PG8_SA
#undef PG8_SB
#undef PG8_STAGE
#undef PG8_LDA
#undef PG8_LDB
#undef PG8_MMA
#undef PG8_WAIT_V
#undef PG8_WAIT_L
#undef PG8_BAR
#undef PG8_SCHED
}
}


namespace att {
#define ALAS __attribute__((address_space(3)))
typedef unsigned short bf16_t;
typedef short bf16x8 __attribute__((ext_vector_type(8)));
typedef short s16x4 __attribute__((ext_vector_type(4)));
typedef float f32x16 __attribute__((ext_vector_type(16)));
typedef float f32x2_t __attribute__((ext_vector_type(2)));
typedef __bf16 bf16x2_t __attribute__((ext_vector_type(2)));
typedef unsigned u32x4 __attribute__((ext_vector_type(4)));
typedef unsigned u32x2 __attribute__((ext_vector_type(2)));
constexpr int SEQ = 2048, PJ = 2304, OC = 1024;
constexpr int C_QSB = 0, C_KSB = 512, C_VSB = 1024, C_QSW = 1536, C_KSW = 2048, C_VSW = 2176;
constexpr float LOG2E = 1.4426950408889634f;
constexpr float QSCALE = 0.125f * LOG2E;
constexpr float SB_EXIT = 64.0f;
__device__ __forceinline__ int crow(int r, int hh) { return (r & 3) + 8 * (r >> 2) + 4 * hh; }
__device__ __forceinline__ unsigned cvtpk(float lo, float hi) { f32x2_t v = {lo, hi}; bf16x2_t b = __builtin_convertvector(v, bf16x2_t); return __builtin_bit_cast(unsigned, b); }
__device__ __forceinline__ s16x4 vtr(const ALAS char* p) { typedef short v4i16_t __attribute__((ext_vector_type(4))); return __builtin_bit_cast(s16x4, __builtin_amdgcn_ds_read_tr16_b64_v4i16((ALAS v4i16_t*)p)); }
__device__ __forceinline__ float xhalf(float v) { return __shfl_xor(v, 32); }

struct VRegs { u32x4 v[4]; };
__device__ __forceinline__ void v_load(VRegs& R, const bf16_t* vtile, int lane) {
#pragma unroll
    for (int i = 0; i < 4; ++i) { const int id = i * 64 + lane, key = id >> 3, c = id & 7; R.v[i] = *(const u32x4*)(vtile + (size_t)key * PJ + c * 8); }
}
__device__ __forceinline__ void v_store(const VRegs& R, ALAS char* vl, int lane) {
#pragma unroll
    for (int i = 0; i < 4; ++i) { const int id = i * 64 + lane, key = id >> 3, c = id & 7; *(ALAS u32x4*)(vl + (c >> 2) * 2048 + key * 64 + (c & 3) * 16) = R.v[i]; }
}
__device__ __forceinline__ void pv_tile(f32x16& o0, f32x16& o1, const float (&w)[16], const ALAS char* vl, int lane) {
    const int hh = lane >> 5;
    const ALAS char* vb = vl + ((lane >> 4) & 1) * 32 + (lane & 3) * 8 + (4 * hh + ((lane & 15) >> 2)) * 64;
    u32x4 p0, p1;
    p0.x = cvtpk(w[0], w[1]); p0.y = cvtpk(w[2], w[3]); p0.z = cvtpk(w[4], w[5]); p0.w = cvtpk(w[6], w[7]);
    p1.x = cvtpk(w[8], w[9]); p1.y = cvtpk(w[10], w[11]); p1.z = cvtpk(w[12], w[13]); p1.w = cvtpk(w[14], w[15]);
    const bf16x8 pf0 = __builtin_bit_cast(bf16x8, p0), pf1 = __builtin_bit_cast(bf16x8, p1);
#define ATT_VFR(dt, s) ({ const s16x4 lo_ = vtr(vb + (dt) * 2048 + (s) * 1024), hi_ = vtr(vb + (dt) * 2048 + (s) * 1024 + 512); (bf16x8){lo_[0], lo_[1], lo_[2], lo_[3], hi_[0], hi_[1], hi_[2], hi_[3]}; })
    o0 = __builtin_amdgcn_mfma_f32_32x32x16_bf16(ATT_VFR(0, 0), pf0, o0, 0, 0, 0);
    o1 = __builtin_amdgcn_mfma_f32_32x32x16_bf16(ATT_VFR(1, 0), pf0, o1, 0, 0, 0);
    o0 = __builtin_amdgcn_mfma_f32_32x32x16_bf16(ATT_VFR(0, 1), pf1, o0, 0, 0, 0);
    o1 = __builtin_amdgcn_mfma_f32_32x32x16_bf16(ATT_VFR(1, 1), pf1, o1, 0, 0, 0);
#undef ATT_VFR
}
__device__ __forceinline__ void load_frag(bf16x8 (&f)[4], const bf16_t* p) {
#pragma unroll
    for (int d0 = 0; d0 < 4; ++d0) f[d0] = *(const bf16x8*)(p + 16 * d0);
}
__device__ __forceinline__ f32x16 qk_tile(const bf16x8 (&kf)[4], const bf16x8 (&qr)[4]) {
    f32x16 s = {};
#pragma unroll
    for (int d0 = 0; d0 < 4; ++d0) s = __builtin_amdgcn_mfma_f32_32x32x16_bf16(kf[d0], qr[d0], s, 0, 0, 0);
    return s;
}

__device__ __forceinline__ void sb_item(const bf16_t* proj, int b, int h, int qt, ALAS char* vl, f32x16& o0, f32x16& o1, int lane) {
    const int ql = lane & 31, hh = lane >> 5; const size_t rowb = (size_t)b * SEQ;
    bf16x8 qr[4]; load_frag(qr, proj + (rowb + 32 * qt + ql) * PJ + C_QSB + h * 64 + hh * 8);
    o0 = f32x16{}; o1 = f32x16{}; float R = 0.f;
    for (int kt = qt; kt >= 0; --kt) {
        bf16x8 kf[4]; load_frag(kf, proj + (rowb + 32 * kt + ql) * PJ + C_KSB + h * 64 + hh * 8);
        VRegs vr; v_load(vr, proj + (rowb + 32 * kt) * PJ + C_VSB + h * 64, lane);
        const f32x16 s = qk_tile(kf, qr);
        const bool diag = (kt == qt);
        float sp[16];
#pragma unroll
        for (int r = 0; r < 16; ++r) { const float z = s[r]; const float e = __builtin_amdgcn_exp2f(-__builtin_fabsf(z)); float v = __builtin_fmaxf(z, 0.f) + __builtin_amdgcn_logf(1.0f + e);
            if (diag && crow(r, hh) >= ql) v = 0.f; sp[r] = v; }
        float g[4], pg[4];
#pragma unroll
        for (int i = 0; i < 4; ++i) { g[i] = (sp[4 * i] + sp[4 * i + 1]) + (sp[4 * i + 2] + sp[4 * i + 3]); pg[i] = xhalf(g[i]); }
        const float T1 = g[1] + pg[1], T2 = g[2] + pg[2], T3 = g[3] + pg[3], T0 = g[0] + pg[0];
        float off[4]; off[3] = 0.f; off[2] = T3; off[1] = T3 + T2; off[0] = (T3 + T2) + T1;
        const float tot = off[0] + T0;
        float w[16];
#pragma unroll
        for (int i = 0; i < 4; ++i) { float c = R + off[i] + (hh == 0 ? pg[i] : 0.f);
#pragma unroll
            for (int j = 3; j >= 0; --j) { c += sp[4 * i + j]; float wv = __builtin_amdgcn_exp2f(s[4 * i + j] - c); if (diag && crow(4 * i + j, hh) >= ql) wv = 0.f; w[4 * i + j] = wv; } }
        R += tot;
        v_store(vr, vl, lane);
        pv_tile(o0, o1, w, vl, lane);
        if (__all(R > SB_EXIT)) break;
    }
}
__device__ __forceinline__ void swa_item(const bf16_t* proj, int b, int hq, int qt, ALAS char* vl, const ALAS float* tb, float sink2, f32x16& o0, f32x16& o1, int lane) {
    const int ql = lane & 31, hh = lane >> 5, kvh = hq >> 2; const size_t rowb = (size_t)b * SEQ;
    bf16x8 qr[4]; load_frag(qr, proj + (rowb + 32 * qt + ql) * PJ + C_QSW + hq * 64 + hh * 8);
    o0 = f32x16{}; o1 = f32x16{}; float m = sink2, l = 1.0f;
    for (int kt = (qt > 4 ? qt - 4 : 0); kt <= qt; ++kt) {
        bf16x8 kf[4]; load_frag(kf, proj + (rowb + 32 * kt + ql) * PJ + C_KSW + kvh * 64 + hh * 8);
        VRegs vr; v_load(vr, proj + (rowb + 32 * kt) * PJ + C_VSW + kvh * 64, lane);
        const f32x16 s = qk_tile(kf, qr);
        const int dbase = 32 * (qt - kt) + ql;
        float sc[16]; float mx = -1e30f;
#pragma unroll
        for (int r = 0; r < 16; ++r) { const int dist = dbase - crow(r, hh); const bool ok = (dist >= 0) && (dist < 128); const int idx = dist < 0 ? 0 : (dist > 127 ? 127 : dist);
            const float v = ok ? s[r] + tb[idx] : -1e30f; sc[r] = v; mx = __builtin_fmaxf(mx, v); }
        mx = __builtin_fmaxf(mx, xhalf(mx));
        const float mn = __builtin_fmaxf(m, mx), alpha = __builtin_amdgcn_exp2f(m - mn); m = mn;
        float w[16]; float ls = 0.f;
#pragma unroll
        for (int r = 0; r < 16; ++r) { w[r] = __builtin_amdgcn_exp2f(sc[r] - mn); ls += w[r]; }
        ls += xhalf(ls); l = l * alpha + ls;
        o0 *= alpha; o1 *= alpha;
        v_store(vr, vl, lane);
        pv_tile(o0, o1, w, vl, lane);
    }
    const float rl = 1.0f / l; o0 *= rl; o1 *= rl;
}
__device__ __forceinline__ void norm_store(f32x16& o0, f32x16& o1, bf16_t* ocat, int b, int qt, int colh, ALAS char* vl, ALAS float* ssb, int wid, int lane) {
    const int ql = lane & 31, hh = lane >> 5;
    float ss = 0.f;
#pragma unroll
    for (int r = 0; r < 16; ++r) ss += o0[r] * o0[r] + o1[r] * o1[r];
    ss += xhalf(ss);
    if (hh == 0) ssb[wid * 32 + ql] = ss;
    asm volatile("s_waitcnt lgkmcnt(0)" ::: "memory"); __builtin_amdgcn_s_barrier(); asm volatile("" ::: "memory");
    float tot = 0.f;
#pragma unroll
    for (int w8 = 0; w8 < 8; ++w8) tot += ssb[w8 * 32 + ql];
    const float rs = __builtin_amdgcn_rsqf(tot * (1.0f / 512.0f) + 1e-6f);
#pragma unroll
    for (int dt = 0; dt < 2; ++dt)
#pragma unroll
        for (int i = 0; i < 4; ++i) { const f32x16& o = dt ? o1 : o0; u32x2 pk; pk.x = cvtpk(o[4 * i] * rs, o[4 * i + 1] * rs); pk.y = cvtpk(o[4 * i + 2] * rs, o[4 * i + 3] * rs);
            *(ALAS u32x2*)(vl + ql * 128 + (((4 * dt + i) ^ (ql & 7)) << 4) + hh * 8) = pk; }
    asm volatile("s_waitcnt lgkmcnt(0)" ::: "memory");
    bf16_t* orow = ocat + ((size_t)b * SEQ + 32 * qt) * OC + colh;
#pragma unroll
    for (int i = 0; i < 4; ++i) { const int id = i * 64 + lane, row = id >> 3, c = id & 7; const u32x4 v = *(const ALAS u32x4*)(vl + row * 128 + ((c ^ (row & 7)) << 4));
        *(u32x4*)(orow + (size_t)row * OC + c * 8) = v; }
    asm volatile("s_waitcnt lgkmcnt(0)" ::: "memory");
}
constexpr int L_V = 0, L_SS = 32768, L_TB = 34816, L_END = 38912;
__device__ __forceinline__ void attn_phase(ALAS char* lds, const bf16_t* proj, bf16_t* ocat, const float* sinks, const float* rel_bias, int vcu, int wid, int lane) {
    ALAS char* vl = lds + L_V + wid * 4096; ALAS float* ssb = (ALAS float*)(lds + L_SS); ALAS float* tb = (ALAS float*)(lds + L_TB) + wid * 128;
#pragma unroll
    for (int i = 0; i < 2; ++i) { const int d = i * 64 + lane; int bk = d;
        if (d >= 16) { bk = 16 + (int)(__builtin_amdgcn_logf((float)d * (1.0f / 16.0f)) * (16.0f / 3.0f)); bk = bk > 31 ? 31 : bk; }
        tb[d] = rel_bias[bk * 8 + wid] * LOG2E; }
    const float sink2 = sinks[wid] * LOG2E;
    asm volatile("s_waitcnt lgkmcnt(0)" ::: "memory");
    const int b = vcu >> 5, p = vcu & 31;
    f32x16 o0, o1;
#pragma unroll 1
    for (int it = 0; it < 4; ++it) {
        const int qt = (it & 1) ? 63 - p : p;
        if (it < 2) sb_item(proj, b, wid, qt, vl, o0, o1, lane); else swa_item(proj, b, wid, qt, vl, tb, sink2, o0, o1, lane);
        norm_store(o0, o1, ocat, b, qt, (it < 2 ? 0 : 512) + wid * 64, vl, ssb + (it & 1) * 256, wid, lane);
    }
}
#undef ALAS
}

constexpr int NWAVES = 8;
#ifndef MK_PER_PHASE
#define MK_PER_PHASE 0
#endif
#ifndef MK_REPEAT
#define MK_REPEAT 0
#endif
constexpr int DEPTH = 2, BATCH = 8, SEQ = 2048, DM = 1024, M = BATCH * SEQ, DFF = 2816, NGU = 2 * DFF, NIN = 2304;
constexpr int N_PHASES = 2 + 7 * DEPTH;
constexpr size_t MiB = 1u << 20;
constexpr size_t WS_CTL = 0, CTL_ZERO_BYTES = 64 * 1024;
constexpr size_t WS_W = 1 * MiB;
constexpr size_t W_GU = (size_t)NGU * DM * 2, W_D = (size_t)DM * DFF * 2, W_IN = (size_t)NIN * DM * 2, W_OUT = (size_t)DM * DM * 2;
constexpr size_t WL_GU1 = 0, WL_D1 = WL_GU1 + W_GU, WL_IN = WL_D1 + W_D, WL_OUT = WL_IN + W_IN, WL_GU2 = WL_OUT + W_OUT, WL_D2 = WL_GU2 + W_GU, WL_SIZE = WL_D2 + W_D;
constexpr size_t WS_HB = WS_W + DEPTH * WL_SIZE;
constexpr size_t WS_ACT = WS_HB + (size_t)M * DM * 2;
constexpr size_t WS_OCAT = WS_ACT + (size_t)M * DFF * 2;
constexpr size_t WS_SSP = WS_OCAT + (size_t)M * DM * 2;
constexpr size_t WS_END = WS_SSP + (size_t)M * 16;
static_assert(WS_END <= 256 * MiB && WS_HB % 256 == 0 && WS_ACT % 256 == 0 && WS_OCAT % 256 == 0 && WS_SSP % 256 == 0, "d_ws map");
constexpr int CW_BAR = 1024;
constexpr int RING_OFF = 0, RING_BYTES = 131072, MISC_OFF = RING_BYTES + 320, LDS_BYTES = 147456;

#define GAS __attribute__((address_space(1)))
#define LAS __attribute__((address_space(3)))
typedef unsigned short bf16;
typedef unsigned v4u __attribute__((ext_vector_type(4)));
typedef float f32x4 __attribute__((ext_vector_type(4)));
#define LDS_WAIT() asm volatile("s_waitcnt lgkmcnt(0)" ::: "memory")
#define VM_WAIT() asm volatile("s_waitcnt vmcnt(0)" ::: "memory")
__device__ __forceinline__ unsigned f2bf(float f) { unsigned u = __builtin_bit_cast(unsigned, f); return (u + 0x7fffu + ((u >> 16) & 1u)) >> 16; }
__device__ __forceinline__ unsigned pk2(float lo, float hi) { return f2bf(lo) | (f2bf(hi) << 16); }
__device__ __forceinline__ float wave_sum(float v) {
#pragma unroll
    for (int o = 1; o < 64; o <<= 1) v += __shfl_xor(v, o);
    return v;
}

#define XB_TMO      128
#define XB_XCNT(j)  (256  + 64 * (j))
#define XB_XSUB(j)  (1280 + 64 * (j))
#define XB_XGEN(j)  (2304 + 64 * (j))
#define XB_TOP      3328
#define XB_TOPGEN   3392
#define XCD_BAR_WORDS 3456
#define XB_SPIN_CAP (1u << 18)

__device__ __forceinline__ unsigned xb_ld(unsigned* p)              { return __hip_atomic_load(p, __ATOMIC_RELAXED, __HIP_MEMORY_SCOPE_AGENT); }
__device__ __forceinline__ unsigned xb_add(unsigned* p, unsigned v) { return __hip_atomic_fetch_add(p, v, __ATOMIC_RELAXED, __HIP_MEMORY_SCOPE_AGENT); }
__device__ __forceinline__ unsigned xb_xcc_id() { return (unsigned)__builtin_amdgcn_s_getreg((3 << 11) | 20) & 0xFu; }
#define XB_SPIN(cond, bar) do { unsigned _sp = 0; while (cond) { __builtin_amdgcn_s_sleep(1); \
    if ((++_sp & 255u) == 0u) { if (xb_ld(&(bar)[XB_TMO])) break; if (_sp > XB_SPIN_CAP) { atomicAdd(&(bar)[XB_TMO], 1u); break; } } } } while (0)

struct XcdBarrier {
    unsigned* bar; unsigned x;
    volatile LAS unsigned* st;
};

__device__ __forceinline__ XcdBarrier xcd_barrier_post(unsigned* bar, volatile LAS unsigned* st) {
    XcdBarrier b; b.bar = bar; b.x = xb_xcc_id(); b.st = st;
    if (threadIdx.x == 0) (void)xb_add(&bar[XB_XCNT(b.x)], 1u);
    return b;
}
__device__ __forceinline__ void xcd_barrier_complete(unsigned* bar, unsigned x, unsigned& nloc, unsigned& nx) {
    const unsigned G = gridDim.x * gridDim.y * gridDim.z;
    unsigned sum, cnt, mine, sp = 0u;
    for (;;) {
        sum = 0u; cnt = 0u; mine = 0u;
#pragma unroll
        for (unsigned j = 0; j < 16; ++j) { const unsigned c = xb_ld(&bar[XB_XCNT(j)]); sum += c; cnt += (c > 0u) ? 1u : 0u; mine = (j == x) ? c : mine; }
        if (sum == G) break;
        __builtin_amdgcn_s_sleep(1);
        if ((++sp & 255u) == 0u) { if (xb_ld(&bar[XB_TMO])) break; if (sp > XB_SPIN_CAP) { atomicAdd(&bar[XB_TMO], 1u); break; } }
    }
    nloc = mine > 0u ? mine : 1u; nx = cnt > 0u ? cnt : 1u;
}

__device__ __forceinline__ void xcd_barrier(const XcdBarrier& b) {
    asm volatile("s_waitcnt vmcnt(0)" ::: "memory");
    __syncthreads();
    if (threadIdx.x == 0) {
        unsigned* bar = b.bar;
        __builtin_amdgcn_s_waitcnt(0);
        unsigned nloc = b.st[0], nx = b.st[1];
        if (nloc == 0u) { xcd_barrier_complete(bar, b.x, nloc, nx); b.st[0] = nloc; b.st[1] = nx; }
        const unsigned old = xb_add(&bar[XB_XSUB(b.x)], 1u);
        const unsigned gen = old / nloc;
        if (old + 1u == (gen + 1u) * nloc) {
            __builtin_amdgcn_fence(__ATOMIC_RELEASE, "agent");
            asm volatile("s_waitcnt vmcnt(0)" ::: "memory");
            const unsigned og = xb_add(&bar[XB_TOP], 1u);
            const unsigned tg = og / nx;
            if (og + 1u == (tg + 1u) * nx) xb_add(&bar[XB_TOPGEN], 1u);
            else XB_SPIN(xb_ld(&bar[XB_TOPGEN]) == tg, bar);
            __builtin_amdgcn_fence(__ATOMIC_ACQUIRE, "agent");
            xb_add(&bar[XB_XGEN(b.x)], 1u);
            asm volatile("s_waitcnt vmcnt(0)" ::: "memory");
        } else {
            XB_SPIN(xb_ld(&bar[XB_XGEN(b.x)]) == gen, bar);
            __builtin_amdgcn_fence(__ATOMIC_ACQUIRE, "agent");
            asm volatile("s_waitcnt vmcnt(0)" ::: "memory");
        }
    }
    __syncthreads();
}


__device__ __forceinline__ void p0_item(const float* W, int ldw, int src_col0, const float* gain, bf16* WT, int K, int dst_row0, int k0, LAS float* scr, int lane) {
#pragma unroll
    for (int i = 0; i < 8; ++i) { const int kk = i * 8 + (lane >> 3), c4 = (lane & 7) * 4; f32x4 v = *(const f32x4*)(W + (size_t)(k0 + kk) * ldw + src_col0 + c4);
        if (gain) v = v * gain[k0 + kk];
        LAS float* s = scr + kk * 33 + c4; s[0] = v[0]; s[1] = v[1]; s[2] = v[2]; s[3] = v[3]; }
    LDS_WAIT(); asm volatile("" ::: "memory");
    const int c = lane & 7;
#pragma unroll
    for (int j = 0; j < 4; ++j) { const int n = (lane >> 3) + 8 * j; const LAS float* s = scr + (8 * c) * 33 + n;
        v4u o; o.x = pk2(s[0 * 33], s[1 * 33]); o.y = pk2(s[2 * 33], s[3 * 33]); o.z = pk2(s[4 * 33], s[5 * 33]); o.w = pk2(s[6 * 33], s[7 * 33]);
        *(v4u*)(WT + (size_t)(dst_row0 + n) * K + k0 + 8 * c) = o; }
    LDS_WAIT(); asm volatile("" ::: "memory");
}
struct Args { const float* in[15]; float* out; unsigned char* ws; int ph_lo, ph_hi; };
__device__ __forceinline__ void p0_weights(const Args& a, LAS float* scr, int gw, int ngw, int lane) {
    constexpr int I_GU = (DM / 64) * (NGU / 32), I_D = (DFF / 64) * (DM / 32), I_IN = (DM / 64) * (NIN / 32), I_OUT = (DM / 64) * (DM / 32);
    constexpr int I_LAYER = 2 * I_GU + 2 * I_D + I_IN + I_OUT;
    for (int it = gw; it < DEPTH * I_LAYER; it += ngw) {
        const int l = it / I_LAYER; int r = it % I_LAYER;
        bf16* wl = (bf16*)(a.ws + WS_W + (size_t)l * WL_SIZE);
        if (r < 2 * I_GU) {
            const int f = r / I_GU; r %= I_GU; const int nb = r % (NGU / 32), kb = r / (NGU / 32), n0 = nb * 32, t = n0 >> 8, j = n0 & 255;
            const int src = (j < 128) ? (128 * t + j) : (DFF + 128 * t + (j - 128));
            p0_item(a.in[f ? 11 : 2] + (size_t)l * DM * NGU, NGU, src, a.in[f ? 10 : 1] + l * DM, (bf16*)((char*)wl + (f ? WL_GU2 : WL_GU1)), DM, n0, kb * 64, scr, lane); continue; }
        r -= 2 * I_GU;
        if (r < 2 * I_D) { const int f = r / I_D; r %= I_D; const int nb = r % (DM / 32), kb = r / (DM / 32);
            p0_item(a.in[f ? 12 : 3] + (size_t)l * DFF * DM, DM, nb * 32, nullptr, (bf16*)((char*)wl + (f ? WL_D2 : WL_D1)), DFF, nb * 32, kb * 64, scr, lane); continue; }
        r -= 2 * I_D;
        if (r < I_IN) { const int nb = r % (NIN / 32), kb = r / (NIN / 32);
            p0_item(a.in[5] + (size_t)l * DM * NIN, NIN, nb * 32, a.in[4] + l * DM, (bf16*)((char*)wl + WL_IN), DM, nb * 32, kb * 64, scr, lane); continue; }
        r -= I_IN;
        { const int nb = r % (DM / 32), kb = r / (DM / 32), k0 = kb * 64;
          const float* gain = (k0 < 512) ? (a.in[7] + l * 512 + k0) - k0 : (a.in[8] + l * 512 + (k0 - 512)) - k0;
          p0_item(a.in[9] + (size_t)l * DM * DM, DM, nb * 32, gain, (bf16*)((char*)wl + WL_OUT), DM, nb * 32, k0, scr, lane); }
    }
}
__device__ __forceinline__ void p0_rows(const float* x, bf16* hb, float* ssp, int gw, int ngw, int lane) {
    for (int m = gw; m < M; m += ngw) {
        const f32x4* xr = (const f32x4*)(x + (size_t)m * DM) + lane; f32x4 v[4]; float s = 0.f;
#pragma unroll
        for (int j = 0; j < 4; ++j) { v[j] = xr[64 * j]; s += (v[j][0] * v[j][0] + v[j][1] * v[j][1]) + (v[j][2] * v[j][2] + v[j][3] * v[j][3]); }
        s = wave_sum(s);
        unsigned long long* o8 = (unsigned long long*)(hb + (size_t)m * DM) + lane;
#pragma unroll
        for (int j = 0; j < 4; ++j) o8[64 * j] = (unsigned long long)pk2(v[j][0], v[j][1]) | ((unsigned long long)pk2(v[j][2], v[j][3]) << 32);
        if (lane == 0) *(f32x4*)(ssp + 4 * (size_t)m) = (f32x4){s, 0.f, 0.f, 0.f};
    }
}
__device__ __forceinline__ void final_rows(float* h, const float* ssp, const float* gain, int gw, int ngw, int lane) {
    f32x4 gv[4];
#pragma unroll
    for (int j = 0; j < 4; ++j) gv[j] = ((const f32x4*)gain)[lane + 64 * j];
    for (int m = gw; m < M; m += ngw) {
        const f32x4 p = *(const f32x4*)(ssp + 4 * (size_t)m); const float rs = __builtin_amdgcn_rsqf(((p[0] + p[1]) + (p[2] + p[3])) * (1.0f / DM) + 1e-6f);
        f32x4* hr = (f32x4*)(h + (size_t)m * DM) + lane;
#pragma unroll
        for (int j = 0; j < 4; ++j) { const f32x4 v = hr[64 * j]; hr[64 * j] = v * rs * gv[j]; }
    }
}

__global__ void __launch_bounds__(NWAVES * 64, 2) hymba_fwd(Args args) {
    extern __shared__ __attribute__((aligned(16))) unsigned char lds_raw[];
    LAS unsigned char* lds = (LAS unsigned char*)lds_raw;
    volatile LAS unsigned* MISC = (volatile LAS unsigned*)(lds + MISC_OFF);
    const int tid = threadIdx.x, lane = tid & 63, wave = __builtin_amdgcn_readfirstlane(tid >> 6);
    const int G = gridDim.x, bx = blockIdx.x, vcu = (G % 8 == 0) ? (bx % 8) * (G / 8) + bx / 8 : bx;
    unsigned char* ws = args.ws;
    for (int u = tid; u < (LDS_BYTES - RING_BYTES) / 4; u += NWAVES * 64) ((LAS unsigned*)(lds + RING_BYTES))[u] = 0u;
    __syncthreads();
    XcdBarrier bar; bar.bar = (unsigned*)(ws + WS_CTL) + CW_BAR; bar.x = 0; bar.st = nullptr;
    if (!MK_PER_PHASE) bar = xcd_barrier_post((unsigned*)(ws + WS_CTL) + CW_BAR, MISC + 8);
    const int lo = args.ph_lo, hi = args.ph_hi;
#define IN(k) (lo <= (k) && (k) < hi)
#define SEAM(k) do { if (IN(k) && IN((k) + 1)) { xcd_barrier(bar); if (MK_REPEAT & 64) xcd_barrier(bar); } } while (0)
#define REP(kind) for (int rep_ = ((MK_REPEAT >> (kind)) & 1); rep_ >= 0; --rep_)
    float* h = args.out;
    bf16* hb = (bf16*)(ws + WS_HB); bf16* act = (bf16*)(ws + WS_ACT); bf16* proj = (bf16*)(ws + WS_ACT); bf16* ocat = (bf16*)(ws + WS_OCAT); float* ssp = (float*)(ws + WS_SSP);
    const int gw = vcu * NWAVES + wave, ngw = G * NWAVES;

    REP(0) if (IN(0)) { p0_weights(args, (LAS float*)(lds + RING_OFF + wave * 16384), gw, ngw, lane); p0_rows(args.in[0], hb, ssp, gw, ngw, lane); SEAM(0); }

#pragma unroll 1
    for (int l = 0; l < DEPTH; ++l) {
        const int pb = 1 + 7 * l;
        const pg8::bf16_t* wl = (const pg8::bf16_t*)(ws + WS_W + (size_t)l * WL_SIZE);
#pragma unroll 1
        for (int f = 0; f < 2; ++f) {
            const int pf = pb + (f ? 5 : 0);
            REP(1) if (IN(pf)) {
                pg8::Gemm g{hb, (const pg8::bf16_t*)((const char*)wl + (f ? WL_GU2 : WL_GU1)), M, NGU, DM}; pg8::StaticOrder S; S.init(M, NGU, G, bx);
                pg8::EpiSwiGLU E{act, DFF, ssp};
                pg8::gemm_phase<pg8::EpiSwiGLU, pg8::StaticOrder, true, true>(lds + RING_OFF, g, S, E);
                SEAM(pf);
            }
            REP(2) if (IN(pf + 1)) {
                pg8::Gemm g{act, (const pg8::bf16_t*)((const char*)wl + (f ? WL_D2 : WL_D1)), M, DM, DFF}; pg8::StaticOrder S; S.init(M, DM, G, bx);
                if (l == DEPTH - 1 && f == 1) { pg8::EpiRes<true> E{h, hb, ssp, rep_ ? 0.0f : 0.5f}; pg8::gemm_phase<pg8::EpiRes<true>, pg8::StaticOrder, false, true>(lds + RING_OFF, g, S, E); }
                else { pg8::EpiRes<false> E{h, hb, ssp, rep_ ? 0.0f : 0.5f}; pg8::gemm_phase<pg8::EpiRes<false>, pg8::StaticOrder, false, true>(lds + RING_OFF, g, S, E); }
                SEAM(pf + 1);
            }
            if (f == 1) break;
            REP(3) if (IN(pb + 2)) {
                pg8::Gemm g{hb, (const pg8::bf16_t*)((const char*)wl + WL_IN), M, NIN, DM}; pg8::StaticOrder S; S.init(M, NIN, G, bx);
                pg8::EpiProj E{proj, NIN, ssp, 0xC3u, att::QSCALE};
                pg8::gemm_phase<pg8::EpiProj, pg8::StaticOrder, true, true>(lds + RING_OFF, g, S, E);
                SEAM(pb + 2);
            }
            REP(4) if (IN(pb + 3)) {
                int t_ = threadIdx.x; asm volatile("" : "+v"(t_));
                att::attn_phase((LAS char*)(lds + RING_OFF), proj, ocat, args.in[6] + l * 8, args.in[13], vcu, __builtin_amdgcn_readfirstlane(t_ >> 6), t_ & 63);
                SEAM(pb + 3);
            }
            REP(5) if (IN(pb + 4)) {
                pg8::Gemm g{ocat, (const pg8::bf16_t*)((const char*)wl + WL_OUT), M, DM, DM}; pg8::StaticOrder S; S.init(M, DM, G, bx);
                pg8::EpiRes<false> E{h, hb, ssp, rep_ ? 0.0f : 1.0f};
                pg8::gemm_phase<pg8::EpiRes<false>, pg8::StaticOrder, false, true>(lds + RING_OFF, g, S, E);
                SEAM(pb + 4);
            }
        }
    }
    if (IN(N_PHASES - 1)) final_rows(h, ssp, args.in[14], gw, ngw, lane);
#undef IN
#undef SEAM
}

extern "C" void kernel_launch(void* const* d_in, const int* in_sizes, int n_in, void* d_out, int out_size, void* d_ws, size_t ws_size, hipStream_t stream) {
    static int grid = 0;
    if (grid == 0) {
        if (n_in != 15 || in_sizes[0] != M * DM || out_size != M * DM || ws_size < WS_END) { fprintf(stderr, "kernel_launch: unexpected shapes (n_in %d, x %d, out %d, ws %zu); nothing launched\n", n_in, n_in > 0 ? in_sizes[0] : -1, out_size, ws_size); grid = -1; return; }
        int dev = 0, cus = 0, per_cu = 0;
        if (hipGetDevice(&dev) != hipSuccess || hipDeviceGetAttribute(&cus, hipDeviceAttributeMultiprocessorCount, dev) != hipSuccess) { grid = -1; return; }
        if (hipFuncSetAttribute((const void*)hymba_fwd, hipFuncAttributeMaxDynamicSharedMemorySize, LDS_BYTES) != hipSuccess) { fprintf(stderr, "kernel_launch: hipFuncSetAttribute failed\n"); grid = -1; return; }
        if (hipOccupancyMaxActiveBlocksPerMultiprocessor(&per_cu, (const void*)hymba_fwd, NWAVES * 64, LDS_BYTES) != hipSuccess || per_cu < 1) { fprintf(stderr, "kernel_launch: occupancy query says %d blocks per CU\n", per_cu); per_cu = 1; }
        (void)hipGetLastError();
        grid = cus;
        if (grid != 256) fprintf(stderr, "kernel_launch: %d CUs; this kernel is laid out for 256 (one 256x256 unit per workgroup in the N = 1024 GEMM phases)\n", grid);
    }
    if (grid < 0) return;
    Args a{};
    for (int i = 0; i < 15; ++i) a.in[i] = (const float*)d_in[i];
    a.out = (float*)d_out; a.ws = (unsigned char*)d_ws;
#if MK_PER_PHASE
    for (int p = 0; p < N_PHASES; ++p) { a.ph_lo = p; a.ph_hi = p + 1; hipLaunchKernelGGL(hymba_fwd, dim3(grid), dim3(NWAVES * 64), LDS_BYTES, stream, a); }
#else
    (void)hipMemsetAsync((char*)d_ws + WS_CTL, 0, CTL_ZERO_BYTES, stream);
    a.ph_lo = 0; a.ph_hi = N_PHASES;
    void* kargs[] = {&a};
    hipError_t e = hipLaunchCooperativeKernel((const void*)hymba_fwd, dim3(grid), dim3(NWAVES * 64), kargs, LDS_BYTES, stream);
    if (e != hipSuccess) fprintf(stderr, "kernel_launch: cooperative launch failed: %s (grid %d)\n", hipGetErrorString(e), grid);
#endif
}
```

```cpp
#include <hip/hip_runtime.h>
#include <cstdio>
#include <cstdint>

namespace pg8 {
#define PG8_LAS __attribute__((address_space(3)))
typedef unsigned short bf16_t;
typedef short bf16x8 __attribute__((ext_vector_type(8)));
typedef float f32x4 __attribute__((ext_vector_type(4)));
typedef unsigned u32x4 __attribute__((ext_vector_type(4)));
constexpr int BM = 256, BK = 64, HALF = 128, HTB = HALF * BK * 2  , STAGE_BYTES = 8 * HTB, NXCD = 8, WGM = 8;

__host__ __device__ __forceinline__ int lds_byte(int r, int c) { const int st = (r >> 4) * 2 + (c >> 5), rr = r & 15, cc = c & 31, ob = rr * 64 + cc * 2; return st * 1024 + (ob ^ (((ob >> 9) & 1) << 5)); }
__host__ __device__ __forceinline__ void stage_rc(int b, int& R, int& C) { const int st = b / 1024, sb = b % 1024, swz = sb ^ (((sb >> 9) & 1) << 5); R = (st >> 1) * 16 + swz / 64; C = (st & 1) * 32 + (swz % 64) / 2; }
__host__ __device__ __forceinline__ int perm32(int rho) { const int n = rho >> 4, i = rho & 15; return 8 * (i >> 2) + 4 * n + (i & 3); }

struct Unit { int pm, pn, half; };
struct Gemm { const bf16_t* A; const bf16_t* Bt; int M, N, K; };

struct StaticOrder {
    int nM, nN, nwg, G, c, nfr; bool halves;
    __host__ __device__ void init(int M, int N, int G_, int c_) { nM = M / BM; nN = N / BM; nwg = nM * nN; G = G_; c = c_; nfr = nwg / G; const int R = nwg - nfr * G; halves = (R > 0) && !(R & 7) && (4 * R <= G); }
    __host__ __device__ bool next(int i, Unit& u) const {
        long L = (long)i * G + c; u.half = 0;
        if (i >= nfr) { const int R = nwg - nfr * G; if (i > nfr) return false;
            if (halves) { if (c >= 2 * R) return false; L = (long)nfr * G + (c & 7) + 8 * (c >> 4); u.half = 1 + ((c >> 3) & 1); } else if (c >= R) return false; }
        int wgid = (int)L; { const int q = nwg / NXCD, r = nwg % NXCD, xcd = wgid % NXCD, off = wgid / NXCD; wgid = (xcd < r ? xcd * (q + 1) : r * (q + 1) + (xcd - r) * q) + off; }
        const int nig = WGM * nN, gid = wgid / nig, fm = gid * WGM, gsz = (nM - fm) < WGM ? (nM - fm) : WGM;
        u.pm = fm + ((wgid % nig) % gsz); u.pn = (wgid % nig) / gsz; return true;
    }
    __device__ __forceinline__ void a_ready(const Unit&) const {}
    __device__ __forceinline__ void done(const Unit&) const {}
};

__device__ __forceinline__ unsigned cvt_pk_bf16(float lo, float hi) { unsigned r; asm volatile("v_cvt_pk_bf16_f32 %0, %1, %2" : "=v"(r) : "v"(lo), "v"(hi)); return r; }
constexpr float RMS_EPS = 1e-6f;
__device__ __forceinline__ float row_rstd(const float* ssp, int row, float inv_n) { const f32x4 p = *(const f32x4*)(ssp + 4 * (size_t)row); return __builtin_amdgcn_rsqf(((p[0] + p[1]) + (p[2] + p[3])) * inv_n + RMS_EPS); }
__device__ __forceinline__ void row_rstd8(float (&rs)[2][4], const float* ssp, int row0, float sc, int hstride = HALF) {
    f32x4 p[8];
#pragma unroll
    for (int i = 0; i < 8; ++i) p[i] = *(const f32x4*)(ssp + 4 * (size_t)(row0 + (i >> 2) * hstride + (i & 3) * 16));
    asm volatile("" : "+v"(p[0]), "+v"(p[1]), "+v"(p[2]), "+v"(p[3]), "+v"(p[4]), "+v"(p[5]), "+v"(p[6]), "+v"(p[7]));
#pragma unroll
    for (int i = 0; i < 8; ++i) rs[i >> 2][i & 3] = __builtin_amdgcn_rsqf(((p[i][0] + p[i][1]) + (p[i][2] + p[i][3])) * (1.0f / 1024.0f) + RMS_EPS) * sc;
}
__device__ __forceinline__ float silu_mul(float g, float u) { const float e = __builtin_amdgcn_exp2f(g * -1.4426950408889634f); return g * __builtin_amdgcn_rcpf(1.0f + e) * u; }

struct EpiSwiGLU {
    static constexpr bool PERM = true, AFTER_DRAIN = false;
    bf16_t* O; int ldc; const float* ssp;
    __device__ __forceinline__ void operator()(const f32x4 (&acc)[2][2][4][2], const Unit& u, int wr, int wc, int fr, int fq) const {
        const int row0 = u.pm * BM + (u.half == 2 ? HALF : 0) + wr * 64 + fr, col0 = u.pn * HALF + wc * 32 + 8 * fq, nai = u.half ? 1 : 2;
        float rsv[2][4];
#pragma unroll
        for (int ai = 0; ai < 2; ++ai)
#pragma unroll
            for (int m = 0; m < 4; ++m) rsv[ai][m] = 1.0f;
        row_rstd8(rsv, ssp, row0, 1.0f, u.half ? 0 : HALF);
#pragma unroll
        for (int ai = 0; ai < 2; ++ai) if (ai < nai)
#pragma unroll
            for (int m = 0; m < 4; ++m) { const int row = row0 + ai * HALF + m * 16; const float rs = rsv[ai][m];
                const f32x4 g0 = acc[ai][0][m][0] * rs, g1 = acc[ai][0][m][1] * rs, u0 = acc[ai][1][m][0] * rs, u1 = acc[ai][1][m][1] * rs;
                u32x4 w; w.x = cvt_pk_bf16(silu_mul(g0[0], u0[0]), silu_mul(g0[1], u0[1])); w.y = cvt_pk_bf16(silu_mul(g0[2], u0[2]), silu_mul(g0[3], u0[3]));
                w.z = cvt_pk_bf16(silu_mul(g1[0], u1[0]), silu_mul(g1[1], u1[1])); w.w = cvt_pk_bf16(silu_mul(g1[2], u1[2]), silu_mul(g1[3], u1[3]));
                *(u32x4*)(O + (size_t)row * ldc + col0) = w; }
    }
};
struct EpiProj {
    static constexpr bool PERM = true, AFTER_DRAIN = false;
    bf16_t* O; int ldc; const float* ssp; unsigned qmask; float qscale;
    __device__ __forceinline__ void operator()(const f32x4 (&acc)[2][2][4][2], const Unit& u, int wr, int wc, int fr, int fq) const {
        const int row0 = u.pm * BM + (u.half == 2 ? HALF : 0) + wr * 64 + fr, col0 = u.pn * BM + wc * 32 + 8 * fq, nai = u.half ? 1 : 2;
        const float sc = ((qmask >> u.pn) & 1u) ? qscale : 1.0f;
        float rsv[2][4];
#pragma unroll
        for (int ai = 0; ai < 2; ++ai)
#pragma unroll
            for (int m = 0; m < 4; ++m) rsv[ai][m] = 1.0f;
        row_rstd8(rsv, ssp, row0, sc, u.half ? 0 : HALF);
#pragma unroll
        for (int ai = 0; ai < 2; ++ai) if (ai < nai)
#pragma unroll
            for (int m = 0; m < 4; ++m) { const int row = row0 + ai * HALF + m * 16; const float rs = rsv[ai][m];
#pragma unroll
                for (int bj = 0; bj < 2; ++bj) { const f32x4 v0 = acc[ai][bj][m][0] * rs, v1 = acc[ai][bj][m][1] * rs;
                    u32x4 w; w.x = cvt_pk_bf16(v0[0], v0[1]); w.y = cvt_pk_bf16(v0[2], v0[3]); w.z = cvt_pk_bf16(v1[0], v1[1]); w.w = cvt_pk_bf16(v1[2], v1[3]);
                    *(u32x4*)(O + (size_t)row * ldc + col0 + bj * HALF) = w; } }
    }
};
template <bool F32OUT> struct EpiRes {
    static constexpr bool PERM = true, AFTER_DRAIN = true;
    float* out; bf16_t* hb; float* ssp; float alpha;
    __device__ __forceinline__ void fused(f32x4 (&acc)[2][2][4][2], const Unit& u, int wr, int wc, int fr, int fq, PG8_LAS unsigned char* lds, int wid, int lane) const {
        PG8_LAS float* P = (PG8_LAS float*)lds;
        const int col0 = u.pn * BM + wc * 32 + 8 * fq;
        u32x4 bres[2][4][2];
#pragma unroll
        for (int ai = 0; ai < 2; ++ai)
#pragma unroll
            for (int m = 0; m < 4; ++m)
#pragma unroll
                for (int bj = 0; bj < 2; ++bj) bres[ai][m][bj] = *(const u32x4*)(hb + (size_t)(u.pm * BM + ai * HALF + wr * 64 + m * 16 + fr) * 1024 + col0 + bj * HALF);
#pragma unroll
        for (int ai = 0; ai < 2; ++ai)
#pragma unroll
            for (int m = 0; m < 4; ++m) { const int rl = ai * HALF + wr * 64 + m * 16 + fr; const size_t off = (size_t)(u.pm * BM + rl) * 1024 + col0; float s = 0.f;
#pragma unroll
                for (int bj = 0; bj < 2; ++bj) { const u32x4 b = bres[ai][m][bj];
                    f32x4 v0, v1;
                    v0[0] = __uint_as_float(b.x << 16); v0[1] = __uint_as_float(b.x & 0xffff0000u); v0[2] = __uint_as_float(b.y << 16); v0[3] = __uint_as_float(b.y & 0xffff0000u);
                    v1[0] = __uint_as_float(b.z << 16); v1[1] = __uint_as_float(b.z & 0xffff0000u); v1[2] = __uint_as_float(b.w << 16); v1[3] = __uint_as_float(b.w & 0xffff0000u);
                    v0 = v0 + acc[ai][bj][m][0] * alpha; v1 = v1 + acc[ai][bj][m][1] * alpha;
                    if (F32OUT) { *(f32x4*)(out + off + bj * HALF) = v0; *(f32x4*)(out + off + bj * HALF + 4) = v1; }
                    else { u32x4 w; w.x = cvt_pk_bf16(v0[0], v0[1]); w.y = cvt_pk_bf16(v0[2], v0[3]); w.z = cvt_pk_bf16(v1[0], v1[1]); w.w = cvt_pk_bf16(v1[2], v1[3]);
                        *(u32x4*)(hb + off + bj * HALF) = w; }
                    s += (v0[0] * v0[0] + v0[1] * v0[1]) + (v0[2] * v0[2] + v0[3] * v0[3]) + (v1[0] * v1[0] + v1[1] * v1[1]) + (v1[2] * v1[2] + v1[3] * v1[3]); }
                s += __shfl_xor(s, 16); s += __shfl_xor(s, 32);
                if (fq == 0) P[rl * 4 + wc] = s; }
        asm volatile("s_waitcnt lgkmcnt(0)" ::: "memory"); __builtin_amdgcn_s_barrier(); asm volatile("" ::: "memory");
        const int t = wid * 64 + lane;
        if (t < 256) { const f32x4 p = *(const PG8_LAS f32x4*)(P + t * 4); ssp[(size_t)(u.pm * BM + t) * 4 + u.pn] = (p[0] + p[1]) + (p[2] + p[3]); }
        asm volatile("s_waitcnt lgkmcnt(0)" ::: "memory"); __builtin_amdgcn_s_barrier(); asm volatile("" ::: "memory");
    }
};

template <class Epi, class Sched, bool ALIGN_EPI = false, bool SP2 = false>
__device__ __forceinline__ void gemm_phase(PG8_LAS unsigned char* lds, const Gemm g, const Sched& S, const Epi& E) {
    int tid_ = threadIdx.x; asm volatile("" : "+v"(tid_));
    const int tid = tid_, wid = __builtin_amdgcn_readfirstlane(tid >> 6), lane = tid & 63, wr = wid >> 2, wc = wid & 3, fr = lane & 15, fq = lane >> 4;
    const int K = g.K, nt = K / BK;
    unsigned voffA[2], voffB[2];
#pragma unroll
    for (int i = 0; i < 2; ++i) { int R, C; stage_rc(tid * 16 + i * 8192, R, C); const int Rb = Epi::PERM ? ((R & ~31) + perm32(R & 31)) : R;
        voffA[i] = (unsigned)(R * K + C) * 2u; voffB[i] = (unsigned)(Rb * K + C) * 2u; }
    const size_t kstep = (size_t)(BK * 2);
    const size_t hstep = (size_t)HALF * K * 2;
    const size_t tstep = 2 * hstep;
    const unsigned ldsw = (unsigned)wid * 1024u;
    const int aoff = lds_byte(wr * 64 + fr, fq * 8), boff = lds_byte(wc * 32 + fr, fq * 8);
#define PG8_SA(b, h) (((b) * 2 + (h)) * HTB)
#define PG8_SB(b, h) ((4 + (b) * 2 + (h)) * HTB)
#define PG8_STAGE(bufoff, gbase, voff) do { _Pragma("unroll") for (int _i = 0; _i < 2; ++_i) \
        __builtin_amdgcn_global_load_lds((const unsigned*)((const char*)(gbase) + (voff)[_i]), (PG8_LAS unsigned*)(lds + (bufoff) + ldsw + _i * 8192), 16, 0, 0); } while (0)
#define PG8_LDA(dst, b, h) do { _Pragma("unroll") for (int m = 0; m < 4; ++m) _Pragma("unroll") for (int k = 0; k < 2; ++k) dst[m][k] = *(const PG8_LAS bf16x8*)(lds + PG8_SA(b, h) + aoff + m * 2048 + k * 1024); } while (0)
#define PG8_LDB(dst, b, h) do { _Pragma("unroll") for (int n = 0; n < 2; ++n) _Pragma("unroll") for (int k = 0; k < 2; ++k) dst[n][k] = *(const PG8_LAS bf16x8*)(lds + PG8_SB(b, h) + boff + n * 2048 + k * 1024); } while (0)
#define PG8_MMA(ai, bj, At, Bt) do { __builtin_amdgcn_s_setprio(1); _Pragma("unroll") for (int m = 0; m < 4; ++m) _Pragma("unroll") for (int n = 0; n < 2; ++n) _Pragma("unroll") for (int k = 0; k < 2; ++k) \
        acc[ai][bj][m][n] = __builtin_amdgcn_mfma_f32_16x16x32_bf16(Bt[n][k], At[m][k], acc[ai][bj][m][n], 0, 0, 0); __builtin_amdgcn_s_setprio(0); } while (0)
#define PG8_WAIT_V(n) asm volatile("s_waitcnt vmcnt(" #n ")" ::: "memory")
#define PG8_WAIT_L(n) asm volatile("s_waitcnt lgkmcnt(" #n ")" ::: "memory")
#define PG8_BAR __builtin_amdgcn_s_barrier()
#define PG8_SCHED __builtin_amdgcn_sched_barrier(0)
    Unit cur, nxt; int ui = 0;
    if (!S.next(0, cur)) return;
    f32x4 acc[2][2][4][2];
#pragma unroll
    for (int a = 0; a < 2; ++a)
#pragma unroll
        for (int b = 0; b < 2; ++b)
#pragma unroll
            for (int m = 0; m < 4; ++m)
#pragma unroll
                for (int n = 0; n < 2; ++n) acc[a][b][m][n] = (f32x4){0.f, 0.f, 0.f, 0.f};
    bf16x8 At[4][2], B0[2][2], B1[2][2];
    const char* cA = (const char*)g.A + (size_t)cur.pm * tstep + (cur.half == 2 ? hstep : 0); const char* cB = (const char*)g.Bt + (size_t)cur.pn * tstep;
    size_t hsA = cur.half ? 0 : hstep;
    S.a_ready(cur);
    if constexpr (SP2) {
        PG8_STAGE(PG8_SB(0, 0), cB, voffB); PG8_STAGE(PG8_SB(0, 1), cB + hstep, voffB); PG8_STAGE(PG8_SA(0, 0), cA, voffA); PG8_STAGE(PG8_SA(0, 1), cA + hsA, voffA);
        if (wr == 1) PG8_BAR;
        PG8_WAIT_V(2); PG8_BAR;
        PG8_STAGE(PG8_SB(1, 0), cB + kstep, voffB); PG8_STAGE(PG8_SA(1, 0), cA + kstep, voffA); PG8_STAGE(PG8_SB(1, 1), cB + hstep + kstep, voffB);
        PG8_WAIT_V(6); PG8_BAR;
    } else {
        PG8_STAGE(PG8_SB(0, 0), cB, voffB); PG8_STAGE(PG8_SA(0, 0), cA, voffA); PG8_STAGE(PG8_SB(0, 1), cB + hstep, voffB); PG8_STAGE(PG8_SA(0, 1), cA + hstep, voffA);
        if (wr == 1) PG8_BAR;
        PG8_WAIT_V(4); PG8_BAR;
        PG8_STAGE(PG8_SB(1, 0), cB + kstep, voffB); PG8_STAGE(PG8_SA(1, 0), cA + kstep, voffA); PG8_STAGE(PG8_SB(1, 1), cB + hstep + kstep, voffB);
        PG8_WAIT_V(6); PG8_BAR;
    }
    for (;;) {
        const bool has_next = S.next(ui + 1, nxt);
        const char* nA = has_next ? (const char*)g.A + (size_t)nxt.pm * tstep + (nxt.half == 2 ? hstep : 0) : cA; const char* nB = has_next ? (const char*)g.Bt + (size_t)nxt.pn * tstep : cB;
        const size_t hsN = has_next ? (nxt.half ? 0 : hstep) : hsA; const bool whole = (cur.half == 0);
        for (int t = 0; t < nt; t += 2) {
            const bool last = (t == nt - 2);
            const char* a1 = cA + (size_t)(t + 1) * kstep;
            const char* a2 = last ? nA : cA + (size_t)(t + 2) * kstep; const char* b2 = last ? nB : cB + (size_t)(t + 2) * kstep;
            const char* a3 = a2 + kstep; const char* b3 = b2 + kstep;
            if (last && has_next) S.a_ready(nxt);
            if constexpr (SP2) {
            PG8_LDB(B0, 0, 0); PG8_LDB(B1, 0, 1); PG8_SCHED; PG8_LDA(At, 0, 0); PG8_STAGE(PG8_SA(1, 1), a1 + hsA, voffA);
            PG8_WAIT_V(8); PG8_WAIT_L(0); PG8_BAR; PG8_MMA(0, 0, At, B0); PG8_MMA(0, 1, At, B1); PG8_BAR; PG8_SCHED;
            PG8_LDA(At, 0, 1); PG8_STAGE(PG8_SB(0, 0), b2, voffB); PG8_STAGE(PG8_SB(0, 1), b2 + hstep, voffB); PG8_STAGE(PG8_SA(0, 0), a2, voffA);
            PG8_WAIT_V(8); PG8_WAIT_L(0); PG8_BAR; if (whole) { PG8_MMA(1, 0, At, B0); PG8_MMA(1, 1, At, B1); } PG8_BAR; PG8_SCHED;
            PG8_LDB(B0, 1, 0); PG8_LDB(B1, 1, 1); PG8_SCHED; PG8_LDA(At, 1, 0); PG8_STAGE(PG8_SA(0, 1), a2 + (last ? hsN : hsA), voffA);
            PG8_WAIT_V(8); PG8_WAIT_L(0); PG8_BAR; PG8_MMA(0, 0, At, B0); PG8_MMA(0, 1, At, B1); PG8_BAR; PG8_SCHED;
            PG8_LDA(At, 1, 1); PG8_STAGE(PG8_SB(1, 0), b3, voffB); PG8_STAGE(PG8_SB(1, 1), b3 + hstep, voffB); PG8_STAGE(PG8_SA(1, 0), a3, voffA);
            PG8_WAIT_V(8); PG8_WAIT_L(0); PG8_BAR; if (whole) { PG8_MMA(1, 0, At, B0); PG8_MMA(1, 1, At, B1); } PG8_BAR; PG8_SCHED;
            } else {
            PG8_LDB(B0, 0, 0); PG8_SCHED; PG8_LDA(At, 0, 0); PG8_STAGE(PG8_SA(1, 1), a1 + hstep, voffA);
            PG8_WAIT_L(8); PG8_BAR; PG8_WAIT_L(0); PG8_MMA(0, 0, At, B0); PG8_BAR; PG8_SCHED;
            PG8_LDB(B1, 0, 1); PG8_STAGE(PG8_SB(0, 0), b2, voffB);
            PG8_BAR; PG8_WAIT_L(0); PG8_MMA(0, 1, At, B1); PG8_BAR;
            PG8_LDA(At, 0, 1); PG8_STAGE(PG8_SA(0, 0), a2, voffA);
            PG8_BAR; PG8_WAIT_L(0); PG8_MMA(1, 0, At, B0); PG8_BAR; PG8_SCHED;
            PG8_STAGE(PG8_SB(0, 1), b2 + hstep, voffB);
            PG8_WAIT_V(6); PG8_BAR; PG8_MMA(1, 1, At, B1); PG8_BAR;
            PG8_LDB(B0, 1, 0); PG8_SCHED; PG8_LDA(At, 1, 0); PG8_STAGE(PG8_SA(0, 1), a2 + hstep, voffA);
            PG8_WAIT_L(8); PG8_BAR; PG8_WAIT_L(0); PG8_MMA(0, 0, At, B0); PG8_BAR; PG8_SCHED;
            PG8_LDB(B1, 1, 1); PG8_STAGE(PG8_SB(1, 0), b3, voffB);
            PG8_BAR; PG8_WAIT_L(0); PG8_MMA(0, 1, At, B1); PG8_BAR;
            PG8_LDA(At, 1, 1); PG8_STAGE(PG8_SA(1, 0), a3, voffA);
            PG8_BAR; PG8_WAIT_L(0); PG8_MMA(1, 0, At, B0); PG8_BAR; PG8_SCHED;
            PG8_STAGE(PG8_SB(1, 1), b3 + hstep, voffB);
            PG8_WAIT_V(6); PG8_BAR; PG8_MMA(1, 1, At, B1); PG8_BAR;
            }
        }
        if constexpr (ALIGN_EPI) { if (wr == 0) PG8_BAR; }
        if constexpr (!Epi::AFTER_DRAIN) { E(acc, cur, wr, wc, fr, fq); S.done(cur); }
        if (!has_next) break;
#pragma unroll
        for (int a = 0; a < 2; ++a)
#pragma unroll
            for (int b = 0; b < 2; ++b)
#pragma unroll
                for (int m = 0; m < 4; ++m)
#pragma unroll
                    for (int n = 0; n < 2; ++n) acc[a][b][m][n] = (f32x4){0.f, 0.f, 0.f, 0.f};
        cur = nxt; cA = nA; cB = nB; hsA = hsN; ++ui;
        if constexpr (ALIGN_EPI) { if (wr == 1) PG8_BAR; }
    }
    PG8_WAIT_V(0);
    if constexpr (!ALIGN_EPI) { if (wr == 0) PG8_BAR; }
    PG8_BAR;
    if constexpr (Epi::AFTER_DRAIN) { E.fused(acc, cur, wr, wc, fr, fq, lds, wid, lane); S.done(cur); }
#undef PG8_SA
#undef PG8_SB
#undef PG8_STAGE
#undef PG8_LDA
#undef PG8_LDB
#undef PG8_MMA
#undef PG8_WAIT_V
#undef PG8_WAIT_L
#undef PG8_BAR
#undef PG8_SCHED
}
}


namespace att {
#define ALAS __attribute__((address_space(3)))
typedef unsigned short bf16_t;
typedef short bf16x8 __attribute__((ext_vector_type(8)));
typedef short s16x4 __attribute__((ext_vector_type(4)));
typedef float f32x16 __attribute__((ext_vector_type(16)));
typedef float f32x2_t __attribute__((ext_vector_type(2)));
typedef __bf16 bf16x2_t __attribute__((ext_vector_type(2)));
typedef unsigned u32x4 __attribute__((ext_vector_type(4)));
typedef unsigned u32x2 __attribute__((ext_vector_type(2)));
constexpr int SEQ = 2048, PJ = 2304, OC = 1024;
constexpr int C_QSB = 0, C_KSB = 512, C_VSB = 1024, C_QSW = 1536, C_KSW = 2048, C_VSW = 2176;
constexpr float LOG2E = 1.4426950408889634f;
constexpr float QSCALE = 0.125f * LOG2E;
constexpr float SB_EXIT = 64.0f;
__device__ __forceinline__ int crow(int r, int hh) { return (r & 3) + 8 * (r >> 2) + 4 * hh; }
__device__ __forceinline__ unsigned cvtpk(float lo, float hi) { f32x2_t v = {lo, hi}; bf16x2_t b = __builtin_convertvector(v, bf16x2_t); return __builtin_bit_cast(unsigned, b); }
__device__ __forceinline__ s16x4 vtr(const ALAS char* p) { typedef short v4i16_t __attribute__((ext_vector_type(4))); return __builtin_bit_cast(s16x4, __builtin_amdgcn_ds_read_tr16_b64_v4i16((ALAS v4i16_t*)p)); }
__device__ __forceinline__ float xhalf(float v) { return __shfl_xor(v, 32); }

struct VRegs { u32x4 v[4]; };
__device__ __forceinline__ void v_load(VRegs& R, const bf16_t* vtile, int lane) {
#pragma unroll
    for (int i = 0; i < 4; ++i) { const int id = i * 64 + lane, key = id >> 3, c = id & 7; R.v[i] = *(const u32x4*)(vtile + (size_t)key * PJ + c * 8); }
}
__device__ __forceinline__ void v_store(const VRegs& R, ALAS char* vl, int lane) {
#pragma unroll
    for (int i = 0; i < 4; ++i) { const int id = i * 64 + lane, key = id >> 3, c = id & 7; *(ALAS u32x4*)(vl + (c >> 2) * 2048 + key * 64 + (c & 3) * 16) = R.v[i]; }
}
__device__ __forceinline__ void pv_tile(f32x16& o0, f32x16& o1, const float (&w)[16], const ALAS char* vl, int lane) {
    const int hh = lane >> 5;
    const ALAS char* vb = vl + ((lane >> 4) & 1) * 32 + (lane & 3) * 8 + (4 * hh + ((lane & 15) >> 2)) * 64;
    u32x4 p0, p1;
    p0.x = cvtpk(w[0], w[1]); p0.y = cvtpk(w[2], w[3]); p0.z = cvtpk(w[4], w[5]); p0.w = cvtpk(w[6], w[7]);
    p1.x = cvtpk(w[8], w[9]); p1.y = cvtpk(w[10], w[11]); p1.z = cvtpk(w[12], w[13]); p1.w = cvtpk(w[14], w[15]);
    const bf16x8 pf0 = __builtin_bit_cast(bf16x8, p0), pf1 = __builtin_bit_cast(bf16x8, p1);
#define ATT_VFR(dt, s) ({ const s16x4 lo_ = vtr(vb + (dt) * 2048 + (s) * 1024), hi_ = vtr(vb + (dt) * 2048 + (s) * 1024 + 512); (bf16x8){lo_[0], lo_[1], lo_[2], lo_[3], hi_[0], hi_[1], hi_[2], hi_[3]}; })
    o0 = __builtin_amdgcn_mfma_f32_32x32x16_bf16(ATT_VFR(0, 0), pf0, o0, 0, 0, 0);
    o1 = __builtin_amdgcn_mfma_f32_32x32x16_bf16(ATT_VFR(1, 0), pf0, o1, 0, 0, 0);
    o0 = __builtin_amdgcn_mfma_f32_32x32x16_bf16(ATT_VFR(0, 1), pf1, o0, 0, 0, 0);
    o1 = __builtin_amdgcn_mfma_f32_32x32x16_bf16(ATT_VFR(1, 1), pf1, o1, 0, 0, 0);
#undef ATT_VFR
}
__device__ __forceinline__ void load_frag(bf16x8 (&f)[4], const bf16_t* p) {
#pragma unroll
    for (int d0 = 0; d0 < 4; ++d0) f[d0] = *(const bf16x8*)(p + 16 * d0);
}
__device__ __forceinline__ f32x16 qk_tile(const bf16x8 (&kf)[4], const bf16x8 (&qr)[4]) {
    f32x16 s = {};
#pragma unroll
    for (int d0 = 0; d0 < 4; ++d0) s = __builtin_amdgcn_mfma_f32_32x32x16_bf16(kf[d0], qr[d0], s, 0, 0, 0);
    return s;
}

struct KV { bf16x8 kf[4]; VRegs vr; };
__device__ __forceinline__ void kv_load(KV& t, const bf16_t* kp, const bf16_t* vp, int lane) { load_frag(t.kf, kp); v_load(t.vr, vp, lane); asm volatile("" ::: "memory"); }

__device__ __forceinline__ void sb_step(const KV& t, const bf16x8 (&qr)[4], bool diag, float& R, f32x16& o0, f32x16& o1, ALAS char* vl, int lane) {
    const int ql = lane & 31, hh = lane >> 5;
    const f32x16 s = qk_tile(t.kf, qr);
    float sp[16];
#pragma unroll
    for (int r = 0; r < 16; ++r) { const float z = s[r]; const float e = __builtin_amdgcn_exp2f(-__builtin_fabsf(z)); float v = __builtin_fmaxf(z, 0.f) + __builtin_amdgcn_logf(1.0f + e);
        if (diag && crow(r, hh) >= ql) v = 0.f; sp[r] = v; }
    float g[4], pg[4];
#pragma unroll
    for (int i = 0; i < 4; ++i) { g[i] = (sp[4 * i] + sp[4 * i + 1]) + (sp[4 * i + 2] + sp[4 * i + 3]); pg[i] = xhalf(g[i]); }
    const float T1 = g[1] + pg[1], T2 = g[2] + pg[2], T3 = g[3] + pg[3], T0 = g[0] + pg[0];
    float off[4]; off[3] = 0.f; off[2] = T3; off[1] = T3 + T2; off[0] = (T3 + T2) + T1;
    const float tot = off[0] + T0;
    float w[16];
#pragma unroll
    for (int i = 0; i < 4; ++i) { float c = R + off[i] + (hh == 0 ? pg[i] : 0.f);
#pragma unroll
        for (int j = 3; j >= 0; --j) { c += sp[4 * i + j]; float wv = __builtin_amdgcn_exp2f(s[4 * i + j] - c); if (diag && crow(4 * i + j, hh) >= ql) wv = 0.f; w[4 * i + j] = wv; } }
    R += tot;
    v_store(t.vr, vl, lane);
    pv_tile(o0, o1, w, vl, lane);
}
struct ItemIn { bf16x8 qr[4]; KV A; };
__device__ __forceinline__ void sb_begin(ItemIn& in, const bf16_t* proj, int b, int h, int qt, int lane) {
    const int ql = lane & 31, hh = lane >> 5; const size_t rowb = (size_t)b * SEQ;
    load_frag(in.qr, proj + (rowb + 32 * qt + ql) * PJ + C_QSB + h * 64 + hh * 8);
    kv_load(in.A, proj + (rowb + ql + 32 * qt) * PJ + C_KSB + h * 64 + hh * 8, proj + (rowb + 32 * qt) * PJ + C_VSB + h * 64, lane);
}
__device__ __forceinline__ void sb_item(ItemIn& in, const bf16_t* proj, int b, int h, int qt, ALAS char* vl, f32x16& o0, f32x16& o1, int lane) {
    const int ql = lane & 31, hh = lane >> 5; const size_t rowb = (size_t)b * SEQ;
    const bf16_t* kbase = proj + (rowb + ql) * PJ + C_KSB + h * 64 + hh * 8; const bf16_t* vbase = proj + rowb * PJ + C_VSB + h * 64;
    const bf16x8 (&qr)[4] = in.qr; KV& A = in.A; KV B;
    o0 = f32x16{}; o1 = f32x16{}; float R = 0.f; int kt = qt;
    for (;;) {
        bool more = kt > 0; { const int kn = more ? kt - 1 : 0; kv_load(B, kbase + (size_t)(32 * kn) * PJ, vbase + (size_t)(32 * kn) * PJ, lane); }
        sb_step(A, qr, kt == qt, R, o0, o1, vl, lane);
        if (!more || __all(R > SB_EXIT)) break;
        --kt; more = kt > 0; { const int kn = more ? kt - 1 : 0; kv_load(A, kbase + (size_t)(32 * kn) * PJ, vbase + (size_t)(32 * kn) * PJ, lane); }
        sb_step(B, qr, false, R, o0, o1, vl, lane);
        if (!more || __all(R > SB_EXIT)) break;
        --kt;
    }
}
__device__ __forceinline__ void swa_step(const KV& t, const bf16x8 (&qr)[4], int dbase, const ALAS float* tb, float& m, float& l, f32x16& o0, f32x16& o1, ALAS char* vl, int lane) {
    const int hh = lane >> 5;
    const f32x16 s = qk_tile(t.kf, qr);
    float sc[16]; float mx = -1e30f;
#pragma unroll
    for (int r = 0; r < 16; ++r) { const int dist = dbase - crow(r, hh); const int idx = dist < 0 ? 0 : (dist > 127 ? 127 : dist); const float bv = tb[idx];
        float v = s[r] + bv; v = (dist == idx) ? v : -1e30f; sc[r] = v; mx = __builtin_fmaxf(mx, v); }
    mx = __builtin_fmaxf(mx, xhalf(mx));
    const float mn = __builtin_fmaxf(m, mx), alpha = __builtin_amdgcn_exp2f(m - mn); m = mn;
    float w[16]; float ls = 0.f;
#pragma unroll
    for (int r = 0; r < 16; ++r) { w[r] = __builtin_amdgcn_exp2f(sc[r] - mn); ls += w[r]; }
    ls += xhalf(ls); l = l * alpha + ls;
    o0 *= alpha; o1 *= alpha;
    v_store(t.vr, vl, lane);
    pv_tile(o0, o1, w, vl, lane);
}
__device__ __forceinline__ void swa_begin(ItemIn& in, const bf16_t* proj, int b, int hq, int qt, int lane) {
    const int ql = lane & 31, hh = lane >> 5, kvh = hq >> 2; const size_t rowb = (size_t)b * SEQ; const int kt = (qt > 4 ? qt - 4 : 0);
    load_frag(in.qr, proj + (rowb + 32 * qt + ql) * PJ + C_QSW + hq * 64 + hh * 8);
    kv_load(in.A, proj + (rowb + ql + 32 * kt) * PJ + C_KSW + kvh * 64 + hh * 8, proj + (rowb + 32 * kt) * PJ + C_VSW + kvh * 64, lane);
}
__device__ __forceinline__ void swa_item(ItemIn& in, const bf16_t* proj, int b, int hq, int qt, ALAS char* vl, const ALAS float* tb, float sink2, f32x16& o0, f32x16& o1, int lane) {
    const int ql = lane & 31, hh = lane >> 5, kvh = hq >> 2; const size_t rowb = (size_t)b * SEQ;
    const bf16_t* kbase = proj + (rowb + ql) * PJ + C_KSW + kvh * 64 + hh * 8; const bf16_t* vbase = proj + rowb * PJ + C_VSW + kvh * 64;
    const bf16x8 (&qr)[4] = in.qr; KV& A = in.A; KV B;
    int kt = (qt > 4 ? qt - 4 : 0);
    o0 = f32x16{}; o1 = f32x16{}; float m = sink2, l = 1.0f;
    for (;;) {
        bool more = kt < qt; { const int kn = more ? kt + 1 : qt; kv_load(B, kbase + (size_t)(32 * kn) * PJ, vbase + (size_t)(32 * kn) * PJ, lane); }
        swa_step(A, qr, 32 * (qt - kt) + ql, tb, m, l, o0, o1, vl, lane);
        if (!more) break;
        ++kt; more = kt < qt; { const int kn = more ? kt + 1 : qt; kv_load(A, kbase + (size_t)(32 * kn) * PJ, vbase + (size_t)(32 * kn) * PJ, lane); }
        swa_step(B, qr, 32 * (qt - kt) + ql, tb, m, l, o0, o1, vl, lane);
        if (!more) break;
        ++kt;
    }
    const float rl = 1.0f / l; o0 *= rl; o1 *= rl;
}
__device__ __forceinline__ void norm_store(f32x16& o0, f32x16& o1, bf16_t* ocat, int b, int qt, int colh, ALAS char* vl, ALAS float* ssb, int wid, int lane) {
    const int ql = lane & 31, hh = lane >> 5;
    float ss = 0.f;
#pragma unroll
    for (int r = 0; r < 16; ++r) ss += o0[r] * o0[r] + o1[r] * o1[r];
    ss += xhalf(ss);
    if (hh == 0) ssb[wid * 32 + ql] = ss;
    asm volatile("s_waitcnt lgkmcnt(0)" ::: "memory"); __builtin_amdgcn_s_barrier(); asm volatile("" ::: "memory");
    float tot = 0.f;
#pragma unroll
    for (int w8 = 0; w8 < 8; ++w8) tot += ssb[w8 * 32 + ql];
    const float rs = __builtin_amdgcn_rsqf(tot * (1.0f / 512.0f) + 1e-6f);
#pragma unroll
    for (int dt = 0; dt < 2; ++dt)
#pragma unroll
        for (int i = 0; i < 4; ++i) { const f32x16& o = dt ? o1 : o0; u32x2 pk; pk.x = cvtpk(o[4 * i] * rs, o[4 * i + 1] * rs); pk.y = cvtpk(o[4 * i + 2] * rs, o[4 * i + 3] * rs);
            *(ALAS u32x2*)(vl + ql * 128 + (((4 * dt + i) ^ (ql & 7)) << 4) + hh * 8) = pk; }
    asm volatile("s_waitcnt lgkmcnt(0)" ::: "memory");
    bf16_t* orow = ocat + ((size_t)b * SEQ + 32 * qt) * OC + colh;
#pragma unroll
    for (int i = 0; i < 4; ++i) { const int id = i * 64 + lane, row = id >> 3, c = id & 7; const u32x4 v = *(const ALAS u32x4*)(vl + row * 128 + ((c ^ (row & 7)) << 4));
        *(u32x4*)(orow + (size_t)row * OC + c * 8) = v; }
    asm volatile("s_waitcnt lgkmcnt(0)" ::: "memory");
}
constexpr int L_V = 0, L_SS = 32768, L_TB = 34816, L_END = 38912;
__device__ __forceinline__ void attn_phase(ALAS char* lds, const bf16_t* proj, bf16_t* ocat, const float* sinks, const float* rel_bias, int vcu, int wid, int lane) {
    ALAS char* vl = lds + L_V + wid * 4096; ALAS float* ssb = (ALAS float*)(lds + L_SS); ALAS float* tb = (ALAS float*)(lds + L_TB) + wid * 128;
#pragma unroll
    for (int i = 0; i < 2; ++i) { const int d = i * 64 + lane; int bk = d;
        if (d >= 16) { bk = 16 + (int)(__builtin_amdgcn_logf((float)d * (1.0f / 16.0f)) * (16.0f / 3.0f)); bk = bk > 31 ? 31 : bk; }
        tb[d] = rel_bias[bk * 8 + wid] * LOG2E; }
    const float sink2 = sinks[wid] * LOG2E;
    asm volatile("s_waitcnt lgkmcnt(0)" ::: "memory");
    const int b = vcu >> 5, p = vcu & 31, qa = p, qb = 63 - p;
    f32x16 o0, o1; ItemIn in;
    sb_begin(in, proj, b, wid, qa, lane);
    sb_item(in, proj, b, wid, qa, vl, o0, o1, lane);
    sb_begin(in, proj, b, wid, qb, lane);
    norm_store(o0, o1, ocat, b, qa, wid * 64, vl, ssb, wid, lane);
    sb_item(in, proj, b, wid, qb, vl, o0, o1, lane);
    swa_begin(in, proj, b, wid, qa, lane);
    norm_store(o0, o1, ocat, b, qb, wid * 64, vl, ssb + 256, wid, lane);
    swa_item(in, proj, b, wid, qa, vl, tb, sink2, o0, o1, lane);
    swa_begin(in, proj, b, wid, qb, lane);
    norm_store(o0, o1, ocat, b, qa, 512 + wid * 64, vl, ssb, wid, lane);
    swa_item(in, proj, b, wid, qb, vl, tb, sink2, o0, o1, lane);
    norm_store(o0, o1, ocat, b, qb, 512 + wid * 64, vl, ssb + 256, wid, lane);
}
#undef ALAS
}

constexpr int NWAVES = 8;
#ifndef MK_PER_PHASE
#define MK_PER_PHASE 0
#endif
#ifndef MK_REPEAT
#define MK_REPEAT 0
#endif
constexpr int DEPTH = 2, BATCH = 8, SEQ = 2048, DM = 1024, M = BATCH * SEQ, DFF = 2816, NGU = 2 * DFF, NIN = 2304;
constexpr int N_PHASES = 2 + 7 * DEPTH;
constexpr size_t MiB = 1u << 20;
constexpr size_t WS_CTL = 0, CTL_ZERO_BYTES = 64 * 1024;
constexpr size_t WS_W = 1 * MiB;
constexpr size_t W_GU = (size_t)NGU * DM * 2, W_D = (size_t)DM * DFF * 2, W_IN = (size_t)NIN * DM * 2, W_OUT = (size_t)DM * DM * 2;
constexpr size_t WL_GU1 = 0, WL_D1 = WL_GU1 + W_GU, WL_IN = WL_D1 + W_D, WL_OUT = WL_IN + W_IN, WL_GU2 = WL_OUT + W_OUT, WL_D2 = WL_GU2 + W_GU, WL_SIZE = WL_D2 + W_D;
constexpr size_t WS_HB = WS_W + DEPTH * WL_SIZE;
constexpr size_t WS_ACT = WS_HB + (size_t)M * DM * 2;
constexpr size_t WS_OCAT = WS_ACT + (size_t)M * DFF * 2;
constexpr size_t WS_SSP = WS_OCAT + (size_t)M * DM * 2;
constexpr size_t WS_END = WS_SSP + (size_t)M * 16;
static_assert(WS_END <= 256 * MiB && WS_HB % 256 == 0 && WS_ACT % 256 == 0 && WS_OCAT % 256 == 0 && WS_SSP % 256 == 0, "d_ws map");
constexpr int CW_BAR = 1024;
constexpr int RING_OFF = 0, RING_BYTES = 131072, MISC_OFF = RING_BYTES + 320, LDS_BYTES = 147456;

#define GAS __attribute__((address_space(1)))
#define LAS __attribute__((address_space(3)))
typedef unsigned short bf16;
typedef unsigned v4u __attribute__((ext_vector_type(4)));
typedef float f32x4 __attribute__((ext_vector_type(4)));
#define LDS_WAIT() asm volatile("s_waitcnt lgkmcnt(0)" ::: "memory")
#define VM_WAIT() asm volatile("s_waitcnt vmcnt(0)" ::: "memory")
__device__ __forceinline__ unsigned f2bf(float f) { unsigned u = __builtin_bit_cast(unsigned, f); return (u + 0x7fffu + ((u >> 16) & 1u)) >> 16; }
__device__ __forceinline__ unsigned pk2(float lo, float hi) { return f2bf(lo) | (f2bf(hi) << 16); }
__device__ __forceinline__ float wave_sum(float v) {
#pragma unroll
    for (int o = 1; o < 64; o <<= 1) v += __shfl_xor(v, o);
    return v;
}

#define XB_TMO      128
#define XB_XCNT(j)  (256  + 64 * (j))
#define XB_XSUB(j)  (1280 + 64 * (j))
#define XB_XGEN(j)  (2304 + 64 * (j))
#define XB_TOP      3328
#define XB_TOPGEN   3392
#define XCD_BAR_WORDS 3456
#define XB_SPIN_CAP (1u << 18)

__device__ __forceinline__ unsigned xb_ld(unsigned* p)              { return __hip_atomic_load(p, __ATOMIC_RELAXED, __HIP_MEMORY_SCOPE_AGENT); }
__device__ __forceinline__ unsigned xb_add(unsigned* p, unsigned v) { return __hip_atomic_fetch_add(p, v, __ATOMIC_RELAXED, __HIP_MEMORY_SCOPE_AGENT); }
__device__ __forceinline__ unsigned xb_xcc_id() { return (unsigned)__builtin_amdgcn_s_getreg((3 << 11) | 20) & 0xFu; }
#define XB_SPIN(cond, bar) do { unsigned _sp = 0; while (cond) { __builtin_amdgcn_s_sleep(1); \
    if ((++_sp & 255u) == 0u) { if (xb_ld(&(bar)[XB_TMO])) break; if (_sp > XB_SPIN_CAP) { atomicAdd(&(bar)[XB_TMO], 1u); break; } } } } while (0)

struct XcdBarrier {
    unsigned* bar; unsigned x;
    volatile LAS unsigned* st;
};

__device__ __forceinline__ XcdBarrier xcd_barrier_post(unsigned* bar, volatile LAS unsigned* st) {
    XcdBarrier b; b.bar = bar; b.x = xb_xcc_id(); b.st = st;
    if (threadIdx.x == 0) (void)xb_add(&bar[XB_XCNT(b.x)], 1u);
    return b;
}
__device__ __forceinline__ void xcd_barrier_complete(unsigned* bar, unsigned x, unsigned& nloc, unsigned& nx) {
    const unsigned G = gridDim.x * gridDim.y * gridDim.z;
    unsigned sum, cnt, mine, sp = 0u;
    for (;;) {
        sum = 0u; cnt = 0u; mine = 0u;
#pragma unroll
        for (unsigned j = 0; j < 16; ++j) { const unsigned c = xb_ld(&bar[XB_XCNT(j)]); sum += c; cnt += (c > 0u) ? 1u : 0u; mine = (j == x) ? c : mine; }
        if (sum == G) break;
        __builtin_amdgcn_s_sleep(1);
        if ((++sp & 255u) == 0u) { if (xb_ld(&bar[XB_TMO])) break; if (sp > XB_SPIN_CAP) { atomicAdd(&bar[XB_TMO], 1u); break; } }
    }
    nloc = mine > 0u ? mine : 1u; nx = cnt > 0u ? cnt : 1u;
}

__device__ __forceinline__ void xcd_barrier(const XcdBarrier& b) {
    asm volatile("s_waitcnt vmcnt(0)" ::: "memory");
    __syncthreads();
    if (threadIdx.x == 0) {
        unsigned* bar = b.bar;
        __builtin_amdgcn_s_waitcnt(0);
        unsigned nloc = b.st[0], nx = b.st[1];
        if (nloc == 0u) { xcd_barrier_complete(bar, b.x, nloc, nx); b.st[0] = nloc; b.st[1] = nx; }
        const unsigned old = xb_add(&bar[XB_XSUB(b.x)], 1u);
        const unsigned gen = old / nloc;
        if (old + 1u == (gen + 1u) * nloc) {
            __builtin_amdgcn_fence(__ATOMIC_RELEASE, "agent");
            asm volatile("s_waitcnt vmcnt(0)" ::: "memory");
            const unsigned og = xb_add(&bar[XB_TOP], 1u);
            const unsigned tg = og / nx;
            if (og + 1u == (tg + 1u) * nx) xb_add(&bar[XB_TOPGEN], 1u);
            else XB_SPIN(xb_ld(&bar[XB_TOPGEN]) == tg, bar);
            __builtin_amdgcn_fence(__ATOMIC_ACQUIRE, "agent");
            xb_add(&bar[XB_XGEN(b.x)], 1u);
            asm volatile("s_waitcnt vmcnt(0)" ::: "memory");
        } else {
            XB_SPIN(xb_ld(&bar[XB_XGEN(b.x)]) == gen, bar);
            __builtin_amdgcn_fence(__ATOMIC_ACQUIRE, "agent");
            asm volatile("s_waitcnt vmcnt(0)" ::: "memory");
        }
    }
    __syncthreads();
}


__device__ __forceinline__ void p0_item(const float* W, int ldw, int src_col0, const float* gain, bf16* WT, int K, int dst_row0, int k0, LAS float* scr, int lane) {
#pragma unroll
    for (int i = 0; i < 8; ++i) { const int kk = i * 8 + (lane >> 3), c4 = (lane & 7) * 4; f32x4 v = *(const f32x4*)(W + (size_t)(k0 + kk) * ldw + src_col0 + c4);
        if (gain) v = v * gain[k0 + kk];
        LAS float* s = scr + kk * 33 + c4; s[0] = v[0]; s[1] = v[1]; s[2] = v[2]; s[3] = v[3]; }
    LDS_WAIT(); asm volatile("" ::: "memory");
    const int c = lane & 7;
#pragma unroll
    for (int j = 0; j < 4; ++j) { const int n = (lane >> 3) + 8 * j; const LAS float* s = scr + (8 * c) * 33 + n;
        v4u o; o.x = pk2(s[0 * 33], s[1 * 33]); o.y = pk2(s[2 * 33], s[3 * 33]); o.z = pk2(s[4 * 33], s[5 * 33]); o.w = pk2(s[6 * 33], s[7 * 33]);
        *(v4u*)(WT + (size_t)(dst_row0 + n) * K + k0 + 8 * c) = o; }
    LDS_WAIT(); asm volatile("" ::: "memory");
}
struct Args { const float* in[15]; float* out; unsigned char* ws; int ph_lo, ph_hi; };
__device__ __forceinline__ int wmat_items(int kind) { return kind == 0 || kind == 4 ? (DM / 64) * (NGU / 32) : kind == 1 || kind == 5 ? (DFF / 64) * (DM / 32) : kind == 2 ? (DM / 64) * (NIN / 32) : (DM / 64) * (DM / 32); }
__device__ __forceinline__ void convert_item(const Args& a, int mat, int r, LAS float* scr, int lane) {
    const int l = mat / 6, kind = mat % 6;
    bf16* wl = (bf16*)(a.ws + WS_W + (size_t)l * WL_SIZE);
    if (kind == 0 || kind == 4) {
        const int f = kind == 4; const int nb = r % (NGU / 32), kb = r / (NGU / 32), n0 = nb * 32, t = n0 >> 8, jj = n0 & 255;
        const int src = (jj < 128) ? (128 * t + jj) : (DFF + 128 * t + (jj - 128));
        p0_item(a.in[f ? 11 : 2] + (size_t)l * DM * NGU, NGU, src, a.in[f ? 10 : 1] + l * DM, (bf16*)((char*)wl + (f ? WL_GU2 : WL_GU1)), DM, n0, kb * 64, scr, lane);
    } else if (kind == 1 || kind == 5) { const int f = kind == 5; const int nb = r % (DM / 32), kb = r / (DM / 32);
        p0_item(a.in[f ? 12 : 3] + (size_t)l * DFF * DM, DM, nb * 32, nullptr, (bf16*)((char*)wl + (f ? WL_D2 : WL_D1)), DFF, nb * 32, kb * 64, scr, lane);
    } else if (kind == 2) { const int nb = r % (NIN / 32), kb = r / (NIN / 32);
        p0_item(a.in[5] + (size_t)l * DM * NIN, NIN, nb * 32, a.in[4] + l * DM, (bf16*)((char*)wl + WL_IN), DM, nb * 32, kb * 64, scr, lane);
    } else { const int nb = r % (DM / 32), kb = r / (DM / 32), k0 = kb * 64;
        const float* gain = (k0 < 512) ? (a.in[7] + l * 512 + k0) - k0 : (a.in[8] + l * 512 + (k0 - 512)) - k0;
        p0_item(a.in[9] + (size_t)l * DM * DM, DM, nb * 32, gain, (bf16*)((char*)wl + WL_OUT), DM, nb * 32, k0, scr, lane); }
}
__device__ __forceinline__ void convert_job(const Args& a, int m0, int m1, int w, int nw, LAS float* scr, int lane) {
    for (int mat = m0; mat < m1; ++mat) { const int n = wmat_items(mat % 6);
        for (int it = w; it < n; it += nw) convert_item(a, mat, it, scr, lane); }
}
__device__ __forceinline__ void p0_rows(const float* x, bf16* hb, float* ssp, int gw, int ngw, int lane) {
    for (int m = gw; m < M; m += ngw) {
        const f32x4* xr = (const f32x4*)(x + (size_t)m * DM) + lane; f32x4 v[4]; float s = 0.f;
#pragma unroll
        for (int j = 0; j < 4; ++j) { v[j] = xr[64 * j]; s += (v[j][0] * v[j][0] + v[j][1] * v[j][1]) + (v[j][2] * v[j][2] + v[j][3] * v[j][3]); }
        s = wave_sum(s);
        unsigned long long* o8 = (unsigned long long*)(hb + (size_t)m * DM) + lane;
#pragma unroll
        for (int j = 0; j < 4; ++j) o8[64 * j] = (unsigned long long)pk2(v[j][0], v[j][1]) | ((unsigned long long)pk2(v[j][2], v[j][3]) << 32);
        if (lane == 0) *(f32x4*)(ssp + 4 * (size_t)m) = (f32x4){s, 0.f, 0.f, 0.f};
    }
}
__device__ __forceinline__ void final_rows(float* h, const float* ssp, const float* gain, int gw, int ngw, int lane) {
    f32x4 gv[4];
#pragma unroll
    for (int j = 0; j < 4; ++j) gv[j] = ((const f32x4*)gain)[lane + 64 * j];
    for (int m = gw; m < M; m += ngw) {
        const f32x4 p = *(const f32x4*)(ssp + 4 * (size_t)m); const float rs = __builtin_amdgcn_rsqf(((p[0] + p[1]) + (p[2] + p[3])) * (1.0f / DM) + 1e-6f);
        f32x4* hr = (f32x4*)(h + (size_t)m * DM) + lane;
#pragma unroll
        for (int j = 0; j < 4; ++j) { const f32x4 v = hr[64 * j]; hr[64 * j] = v * rs * gv[j]; }
    }
}

__global__ void __launch_bounds__(NWAVES * 64, 2) hymba_fwd(Args args) {
    extern __shared__ __attribute__((aligned(16))) unsigned char lds_raw[];
    LAS unsigned char* lds = (LAS unsigned char*)lds_raw;
    volatile LAS unsigned* MISC = (volatile LAS unsigned*)(lds + MISC_OFF);
    const int tid = threadIdx.x, lane = tid & 63, wave = __builtin_amdgcn_readfirstlane(tid >> 6);
    const int G = gridDim.x, bx = blockIdx.x, vcu = (G % 8 == 0) ? (bx % 8) * (G / 8) + bx / 8 : bx;
    unsigned char* ws = args.ws;
    for (int u = tid; u < (LDS_BYTES - RING_BYTES) / 4; u += NWAVES * 64) ((LAS unsigned*)(lds + RING_BYTES))[u] = 0u;
    __syncthreads();
    XcdBarrier bar; bar.bar = (unsigned*)(ws + WS_CTL) + CW_BAR; bar.x = 0; bar.st = nullptr;
    if (!MK_PER_PHASE) bar = xcd_barrier_post((unsigned*)(ws + WS_CTL) + CW_BAR, MISC + 8);
    const int lo = args.ph_lo, hi = args.ph_hi;
#define IN(k) (lo <= (k) && (k) < hi)
#define SEAM(k) do { if (IN(k) && IN((k) + 1)) { xcd_barrier(bar); if (MK_REPEAT & 64) xcd_barrier(bar); } } while (0)
#define REP(kind) for (int rep_ = ((MK_REPEAT >> (kind)) & 1); rep_ >= 0; --rep_)
    float* h = args.out;
    bf16* hb = (bf16*)(ws + WS_HB); bf16* act = (bf16*)(ws + WS_ACT); bf16* proj = (bf16*)(ws + WS_ACT); bf16* ocat = (bf16*)(ws + WS_OCAT); float* ssp = (float*)(ws + WS_SSP);
    const int gw = vcu * NWAVES + wave, ngw = G * NWAVES;

    REP(0) if (IN(0)) { convert_job(args, 0, 1, gw, ngw, (LAS float*)(lds + RING_OFF + wave * 16384), lane); p0_rows(args.in[0], hb, ssp, gw, ngw, lane); SEAM(0); }
#define SLACK_JOB(m0, m1) do { if (bx >= 128) { int t_ = threadIdx.x; asm volatile("" : "+v"(t_)); const int wv_ = __builtin_amdgcn_readfirstlane(t_ >> 6); convert_job(args, (m0), (m1), (bx - 128) * NWAVES + wv_, 128 * NWAVES, (LAS float*)(lds + RING_OFF + wv_ * 16384), t_ & 63); } } while (0)

#pragma unroll 1
    for (int l = 0; l < DEPTH; ++l) {
        const int pb = 1 + 7 * l;
        const pg8::bf16_t* wl = (const pg8::bf16_t*)(ws + WS_W + (size_t)l * WL_SIZE);
#pragma unroll 1
        for (int f = 0; f < 2; ++f) {
            const int pf = pb + (f ? 5 : 0);
            REP(1) if (IN(pf)) {
                pg8::Gemm g{hb, (const pg8::bf16_t*)((const char*)wl + (f ? WL_GU2 : WL_GU1)), M, NGU, DM}; pg8::StaticOrder S; S.init(M, NGU, G, bx);
                pg8::EpiSwiGLU E{act, DFF, ssp};
                pg8::gemm_phase<pg8::EpiSwiGLU, pg8::StaticOrder, true, true>(lds + RING_OFF, g, S, E);
                if (rep_ == 0) { if (f == 0) SLACK_JOB(6 * l + 1, 6 * l + 4); else if (l + 1 < DEPTH) SLACK_JOB(6 * l + 5, 6 * l + 7); else SLACK_JOB(6 * l + 5, 6 * l + 6); }
                SEAM(pf);
            }
            REP(2) if (IN(pf + 1)) {
                pg8::Gemm g{act, (const pg8::bf16_t*)((const char*)wl + (f ? WL_D2 : WL_D1)), M, DM, DFF}; pg8::StaticOrder S; S.init(M, DM, G, bx);
                if (l == DEPTH - 1 && f == 1) { pg8::EpiRes<true> E{h, hb, ssp, rep_ ? 0.0f : 0.5f}; pg8::gemm_phase<pg8::EpiRes<true>, pg8::StaticOrder, false, true>(lds + RING_OFF, g, S, E); }
                else { pg8::EpiRes<false> E{h, hb, ssp, rep_ ? 0.0f : 0.5f}; pg8::gemm_phase<pg8::EpiRes<false>, pg8::StaticOrder, false, true>(lds + RING_OFF, g, S, E); }
                SEAM(pf + 1);
            }
            if (f == 1) break;
            REP(3) if (IN(pb + 2)) {
                pg8::Gemm g{hb, (const pg8::bf16_t*)((const char*)wl + WL_IN), M, NIN, DM}; pg8::StaticOrder S; S.init(M, NIN, G, bx);
                pg8::EpiProj E{proj, NIN, ssp, 0xC3u, att::QSCALE};
                pg8::gemm_phase<pg8::EpiProj, pg8::StaticOrder, true, true>(lds + RING_OFF, g, S, E);
                if (rep_ == 0) SLACK_JOB(6 * l + 4, 6 * l + 5);
                SEAM(pb + 2);
            }
            REP(4) if (IN(pb + 3)) {
                int t_ = threadIdx.x; asm volatile("" : "+v"(t_));
                att::attn_phase((LAS char*)(lds + RING_OFF), proj, ocat, args.in[6] + l * 8, args.in[13], vcu, __builtin_amdgcn_readfirstlane(t_ >> 6), t_ & 63);
                SEAM(pb + 3);
            }
            REP(5) if (IN(pb + 4)) {
                pg8::Gemm g{ocat, (const pg8::bf16_t*)((const char*)wl + WL_OUT), M, DM, DM}; pg8::StaticOrder S; S.init(M, DM, G, bx);
                pg8::EpiRes<false> E{h, hb, ssp, rep_ ? 0.0f : 1.0f};
                pg8::gemm_phase<pg8::EpiRes<false>, pg8::StaticOrder, false, true>(lds + RING_OFF, g, S, E);
                SEAM(pb + 4);
            }
        }
    }
    if (IN(N_PHASES - 1)) final_rows(h, ssp, args.in[14], gw, ngw, lane);
#undef IN
#undef SEAM
}

extern "C" void kernel_launch(void* const* d_in, const int* in_sizes, int n_in, void* d_out, int out_size, void* d_ws, size_t ws_size, hipStream_t stream) {
    static int grid = 0;
    if (grid == 0) {
        if (n_in != 15 || in_sizes[0] != M * DM || out_size != M * DM || ws_size < WS_END) { fprintf(stderr, "kernel_launch: unexpected shapes (n_in %d, x %d, out %d, ws %zu); nothing launched\n", n_in, n_in > 0 ? in_sizes[0] : -1, out_size, ws_size); grid = -1; return; }
        int dev = 0, cus = 0, per_cu = 0;
        if (hipGetDevice(&dev) != hipSuccess || hipDeviceGetAttribute(&cus, hipDeviceAttributeMultiprocessorCount, dev) != hipSuccess) { grid = -1; return; }
        if (hipFuncSetAttribute((const void*)hymba_fwd, hipFuncAttributeMaxDynamicSharedMemorySize, LDS_BYTES) != hipSuccess) { fprintf(stderr, "kernel_launch: hipFuncSetAttribute failed\n"); grid = -1; return; }
        if (hipOccupancyMaxActiveBlocksPerMultiprocessor(&per_cu, (const void*)hymba_fwd, NWAVES * 64, LDS_BYTES) != hipSuccess || per_cu < 1) { fprintf(stderr, "kernel_launch: occupancy query says %d blocks per CU\n", per_cu); per_cu = 1; }
        (void)hipGetLastError();
        grid = cus;
        if (grid != 256) fprintf(stderr, "kernel_launch: %d CUs; this kernel is laid out for 256 (one 256x256 unit per workgroup in the N = 1024 GEMM phases)\n", grid);
    }
    if (grid < 0) return;
    Args a{};
    for (int i = 0; i < 15; ++i) a.in[i] = (const float*)d_in[i];
    a.out = (float*)d_out; a.ws = (unsigned char*)d_ws;
#if MK_PER_PHASE
    for (int p = 0; p < N_PHASES; ++p) { a.ph_lo = p; a.ph_hi = p + 1; hipLaunchKernelGGL(hymba_fwd, dim3(grid), dim3(NWAVES * 64), LDS_BYTES, stream, a); }
#else
    (void)hipMemsetAsync((char*)d_ws + WS_CTL, 0, CTL_ZERO_BYTES, stream);
    a.ph_lo = 0; a.ph_hi = N_PHASES;
    void* kargs[] = {&a};
    hipError_t e = hipLaunchCooperativeKernel((const void*)hymba_fwd, dim3(grid), dim3(NWAVES * 64), kargs, LDS_BYTES, stream);
    if (e != hipSuccess) fprintf(stderr, "kernel_launch: cooperative launch failed: %s (grid %d)\n", hipGetErrorString(e), grid);
#endif
}
```
